# Optimizing an MI355X kernel written in HIP

```python
import jax, jax.numpy as jnp
from jax import lax
import numpy as np

D_MODEL = 1024
BATCH = 16
SEQ = 4096
DEPTH = 1
DEC_BATCH = 8
DEC_SEQ = 32
PAST_LEN = 1024

CHUNK = 64
N_HEADS = 16
HEAD_DIM = D_MODEL // N_HEADS
ATT_DIM = N_HEADS * HEAD_DIM
CONV_DIM = D_MODEL
CONV_GROUPS = 16
CONV_WIDTH = 3
D_FF = ((8 * D_MODEL // 3 + 255) // 256) * 256
Q_BLOCK = 128
N_MOD = 6
EPS = 1e-6
SPLITS = [ATT_DIM, 2 * ATT_DIM, 3 * ATT_DIM,
          3 * ATT_DIM + CONV_DIM, 3 * ATT_DIM + 2 * CONV_DIM, 3 * ATT_DIM + 3 * CONV_DIM,
          3 * ATT_DIM + 3 * CONV_DIM + D_MODEL]
IN_DIM = 3 * ATT_DIM + 3 * CONV_DIM + 2 * D_MODEL

kernel_name = "hybrid_stickbreak_shortconv_convffn_step"


def rms_norm(x, gain):
    x32 = x.astype(jnp.float32)
    y = x32 * lax.rsqrt(jnp.mean(x32 * x32, axis=-1, keepdims=True) + EPS)
    return (y * gain.astype(jnp.float32)).astype(x.dtype)


def modulate(xn, shift, scale):
    return xn * (1 + scale[:, None, :]) + shift[:, None, :]


def causal_dwconv(u, prev, w, b):
    t = u.shape[1]
    u_pad = jnp.concatenate([prev.astype(u.dtype), u], axis=1)
    y = sum((w[i] * u_pad[:, i:i + t] for i in range(CONV_WIDTH)), b)
    return y, u_pad[:, u_pad.shape[1] - (CONV_WIDTH - 1):]


def stick_breaking(q, k, v, q_pos, k_pos):
    z = jnp.einsum("bqhd,bkhd->bhqk", q.astype(jnp.float32), k.astype(jnp.float32)) * (HEAD_DIM ** -0.5)
    mask = k_pos[None, :] < q_pos[:, None]
    log_keep = jnp.where(mask, jax.nn.log_sigmoid(-z), 0.0)
    suffix = lax.cumsum(log_keep, axis=3, reverse=True) - log_keep
    a = jnp.where(mask, jnp.exp(jax.nn.log_sigmoid(z) + suffix), 0.0)
    o = jnp.einsum("bhqk,bkhd->bqhd", a, v.astype(jnp.float32))
    return o.astype(v.dtype)


def stick_breaking_blocked(q, k, v):
    b, t, h, d = q.shape
    nb = t // Q_BLOCK
    qb = q.reshape(b, nb, Q_BLOCK, h, d).transpose(1, 0, 2, 3, 4)
    pb = jnp.arange(t).reshape(nb, Q_BLOCK)
    k_pos = jnp.arange(t)
    ob = lax.map(lambda a: stick_breaking(a[0], k, v, a[1], k_pos), (qb, pb))
    return ob.transpose(1, 0, 2, 3, 4).reshape(b, t, h, d)


def trunk_layer(x, c, past_k, past_v, conv_prev, ffn_prev,
                w_ada, b_ada, g_norm1, w_in, w_conv, b_conv, w_branch_a, w_branch_b, w_out,
                g_norm2, w_up, w_fconv, b_fconv, w_down):
    bsz, t, _ = x.shape
    mod = jax.nn.silu(c) @ w_ada + b_ada
    shift1, scale1, gate1, shift2, scale2, gate2 = jnp.split(mod, N_MOD, axis=-1)

    h = modulate(rms_norm(x, g_norm1), shift1, scale1)
    q, k, v, b_gate, c_gate, u_in, g_a, g_b = jnp.split(h @ w_in, SPLITS, axis=-1)
    q = q.reshape(bsz, t, N_HEADS, HEAD_DIM)
    k = k.reshape(bsz, t, N_HEADS, HEAD_DIM)
    v = v.reshape(bsz, t, N_HEADS, HEAD_DIM)
    if past_k is None:
        o_a = stick_breaking_blocked(q, k, v)
    else:
        p = past_k.shape[1]
        k_all = jnp.concatenate([past_k.astype(k.dtype), k], axis=1)
        v_all = jnp.concatenate([past_v.astype(v.dtype), v], axis=1)
        o_a = stick_breaking(q, k_all, v_all, p + jnp.arange(t), jnp.arange(p + t))
    conv_out, new_conv = causal_dwconv(c_gate * u_in, conv_prev, w_conv, b_conv)
    o_b = b_gate * conv_out
    merged = (jax.nn.sigmoid(g_a) * (o_a.reshape(bsz, t, ATT_DIM) @ w_branch_a)
              + jax.nn.sigmoid(g_b) * (o_b @ w_branch_b))
    x = x + gate1[:, None, :] * (merged @ w_out)

    h2 = modulate(rms_norm(x, g_norm2), shift2, scale2)
    up, gate = jnp.split(h2 @ w_up, 2, axis=-1)
    up_c, new_ffn = causal_dwconv(up, ffn_prev, w_fconv, b_fconv)
    x = x + gate2[:, None, :] * ((jax.nn.silu(up_c) * gate) @ w_down)
    return x, k, v, new_conv, new_ffn


def setup_inputs(seed: int = 0) -> dict:
    key = jax.random.key(seed)
    ks = iter(jax.random.split(key, 32))
    f32 = jnp.float32

    def nrm(shape, scale=1.0):
        return jax.random.normal(next(ks), shape, f32) * scale

    def gain(shape):
        return 1.0 + nrm(shape, 0.02)

    return {
        "x_prompt": nrm((BATCH, SEQ, D_MODEL)),
        "x_sample": nrm((DEC_BATCH, DEC_SEQ, D_MODEL)),
        "cache_k": nrm((DEPTH, DEC_BATCH, PAST_LEN, N_HEADS, HEAD_DIM)),
        "cache_v": nrm((DEPTH, DEC_BATCH, PAST_LEN, N_HEADS, HEAD_DIM)),
        "state_conv": nrm((DEPTH, DEC_BATCH, CONV_WIDTH - 1, CONV_DIM)),
        "state_ffn_conv": nrm((DEPTH, DEC_BATCH, CONV_WIDTH - 1, D_FF)),
        "c_prompt": nrm((BATCH, D_MODEL)),
        "c_sample": nrm((DEC_BATCH, D_MODEL)),
        "w_ada": nrm((DEPTH, D_MODEL, N_MOD * D_MODEL), 0.5 * D_MODEL ** -0.5),
        "b_ada": nrm((DEPTH, N_MOD * D_MODEL), 0.01),
        "g_norm1": gain((DEPTH, D_MODEL)),
        "w_in": nrm((DEPTH, D_MODEL, IN_DIM), D_MODEL ** -0.5),
        "w_conv": nrm((DEPTH, CONV_WIDTH, CONV_DIM), CONV_WIDTH ** -0.5),
        "b_conv": nrm((DEPTH, CONV_DIM), 0.01),
        "w_branch_a": nrm((DEPTH, ATT_DIM, D_MODEL), ATT_DIM ** -0.5),
        "w_branch_b": nrm((DEPTH, CONV_DIM, D_MODEL), CONV_DIM ** -0.5),
        "w_out": nrm((DEPTH, D_MODEL, D_MODEL), D_MODEL ** -0.5),
        "g_norm2": gain((DEPTH, D_MODEL)),
        "w_up": nrm((DEPTH, D_MODEL, 2 * D_FF), D_MODEL ** -0.5),
        "w_fconv": nrm((DEPTH, CONV_WIDTH, D_FF), CONV_WIDTH ** -0.5),
        "b_fconv": nrm((DEPTH, D_FF), 0.01),
        "w_down": nrm((DEPTH, D_FF, D_MODEL), D_FF ** -0.5),
        "g_final": gain((D_MODEL,)),
    }


def reference(x_prompt, x_sample, cache_k, cache_v, state_conv, state_ffn_conv, c_prompt, c_sample,
              w_ada, b_ada, g_norm1, w_in, w_conv, b_conv, w_branch_a, w_branch_b, w_out,
              g_norm2, w_up, w_fconv, b_fconv, w_down, g_final):
    bp = x_prompt.shape[0]
    xp, xs = x_prompt, x_sample
    kp, vp, cp, fp, ks_, vs_, cs_, fs_ = [], [], [], [], [], [], [], []
    for l in range(DEPTH):
        lw = (w_ada[l], b_ada[l], g_norm1[l], w_in[l], w_conv[l], b_conv[l], w_branch_a[l],
              w_branch_b[l], w_out[l], g_norm2[l], w_up[l], w_fconv[l], b_fconv[l], w_down[l])
        zero_conv = jnp.zeros((bp, CONV_WIDTH - 1, CONV_DIM), xp.dtype)
        zero_ffn = jnp.zeros((bp, CONV_WIDTH - 1, D_FF), xp.dtype)
        xp, k1, v1, c1, f1 = trunk_layer(xp, c_prompt, None, None, zero_conv, zero_ffn, *lw)
        xs, k2, v2, c2, f2 = trunk_layer(xs, c_sample, cache_k[l], cache_v[l], state_conv[l],
                                         state_ffn_conv[l], *lw)
        kp.append(k1); vp.append(v1); cp.append(c1); fp.append(f1)
        ks_.append(k2); vs_.append(v2); cs_.append(c2); fs_.append(f2)
    y_prompt = rms_norm(xp, g_final)
    y_sample = rms_norm(xs, g_final)
    return (y_prompt, y_sample,
            jnp.stack(kp), jnp.stack(vp), jnp.stack(cp), jnp.stack(fp),
            jnp.stack(ks_), jnp.stack(vs_), jnp.stack(cs_), jnp.stack(fs_))
```

```cpp
#include <hip/hip_runtime.h>
#include <hip/hip_cooperative_groups.h>
#include <cstdio>
namespace cg = cooperative_groups;

#define LAS __attribute__((address_space(3)))
#define DI __device__ __forceinline__
typedef unsigned short bf16_t;
typedef short bf16x8 __attribute__((ext_vector_type(8)));
typedef short s16x4 __attribute__((ext_vector_type(4)));
typedef float f32x2 __attribute__((ext_vector_type(2)));
typedef float f32x4 __attribute__((ext_vector_type(4)));
typedef float f32x16 __attribute__((ext_vector_type(16)));
typedef unsigned u32x2 __attribute__((ext_vector_type(2)));
typedef unsigned u32x4 __attribute__((ext_vector_type(4)));
typedef __bf16 bf2_t __attribute__((ext_vector_type(2)));

constexpr int D = 1024, NB = 16, T = 4096, MP = NB * T, SB = 8, ST = 32, MS = SB * ST, M = MP + MS;
constexpr int PAST = 1024, SKV = PAST + ST, DFF = 2816, NH = 16, HD = 64, NMOD = 6 * D;
constexpr int N1 = 7168;
constexpr size_t O_Y = 0, O_KP = 67371008, O_VP = 134479872, O_CP = 201588736, O_FP = 201621504, O_KS = 201711616,
                 O_VS = 201973760, O_CS = 202235904, O_FS = 202252288, O_END = 202297344;
constexpr size_t U = (size_t)M * D * 2;
constexpr size_t WS_WIN = 0, WS_WV = WS_WIN + (size_t)N1 * D * 2, WS_WA = WS_WV + (size_t)D * D * 2, WS_WB = WS_WA + (size_t)D * D * 2,
                 WS_WO = WS_WB + (size_t)D * D * 2, WS_WUP = WS_WO + (size_t)D * D * 2, WS_WDN = WS_WUP + (size_t)2 * DFF * D * 2,
                 WS_MOD = WS_WDN + (size_t)D * DFF * 2, WS_KS = WS_MOD + (size_t)24 * NMOD * 4, WS_VTS = WS_KS + (size_t)SB * SKV * D * 2,
                 WS_SLOT0 = WS_VTS + (size_t)SB * D * SKV * 2, WS_BIG = WS_SLOT0 + U,
                 WS_END = WS_BIG + (size_t)M * 2 * DFF * 2;
static_assert((size_t)M * 2 * DFF * 2 >= 5 * U, "big region");
constexpr int LDS_BYTES = 131072;

DI unsigned pk2(float lo, float hi) { f32x2 v = {lo, hi}; return __builtin_bit_cast(unsigned, __builtin_convertvector(v, bf2_t)); }
DI float bflo(unsigned w) { return __uint_as_float(w << 16); }
DI float bfhi(unsigned w) { return __uint_as_float(w & 0xffff0000u); }
DI u32x4 pk8(f32x4 a, f32x4 b) { u32x4 w; w.x = pk2(a[0], a[1]); w.y = pk2(a[2], a[3]); w.z = pk2(b[0], b[1]); w.w = pk2(b[2], b[3]); return w; }
DI float sigmoidf_(float x) { return 1.0f / (1.0f + __expf(-x)); }
DI int bidx_of(int row) { return row < MP ? (row >> 12) : 16 + ((row - MP) >> 5); }

namespace pg8 {
constexpr int BM = 256, BK = 64, HALF = 128, HTB = HALF * BK * 2, STAGE_BYTES = 8 * HTB, NXCD = 8, WGM = 8;
DI int lds_byte(int r, int c) { const int st = (r >> 4) * 2 + (c >> 5), rr = r & 15, cc = c & 31, ob = rr * 64 + cc * 2; return st * 1024 + (ob ^ (((ob >> 9) & 1) << 5)); }
DI void stage_rc(int b, int& R, int& C) { const int st = b / 1024, sb = b % 1024, swz = sb ^ (((sb >> 9) & 1) << 5); R = (st >> 1) * 16 + swz / 64; C = (st & 1) * 32 + (swz % 64) / 2; }
DI int perm32(int rho) { const int n = rho >> 4, i = rho & 15; return 8 * (i >> 2) + 4 * n + (i & 3); }
struct Unit { int pm, pn; };
struct Gemm { const bf16_t* A; const bf16_t* Bt; int M, N, K, lda, ldb; };
struct StaticOrder {
    int nM, nN, nwg, G, c;
    DI void init(int M_, int N_, int G_, int c_) { nM = M_ / BM; nN = N_ / BM; nwg = nM * nN; G = G_; c = c_; }
    DI bool next(int i, Unit& u) const {
        const long L = (long)i * G + c; if (L >= nwg) return false;
        int wgid = (int)L; { const int q = nwg / NXCD, r = nwg % NXCD, xcd = wgid % NXCD, off = wgid / NXCD; wgid = (xcd < r ? xcd * (q + 1) : r * (q + 1) + (xcd - r) * q) + off; }
        const int nig = WGM * nN, gid = wgid / nig, fm = gid * WGM, gsz = (nM - fm) < WGM ? (nM - fm) : WGM;
        u.pm = fm + ((wgid % nig) % gsz); u.pn = (wgid % nig) / gsz; return true;
    }
};

template <class Epi>
DI void gemm_phase(LAS unsigned char* lds, const Gemm g, const StaticOrder& S, const Epi& E) {
    const int tid = threadIdx.x, wid = __builtin_amdgcn_readfirstlane(tid >> 6), lane = tid & 63, wr = wid >> 2, wc = wid & 3, fr = lane & 15, fq = lane >> 4;
    const int K = g.K, nt = K / BK;
    unsigned voffA[2], voffB[2];
#pragma unroll
    for (int i = 0; i < 2; ++i) { int R, C; stage_rc(tid * 16 + i * 8192, R, C); const int Rb = Epi::PERM ? ((R & ~31) + perm32(R & 31)) : R;
        voffA[i] = (unsigned)(R * g.lda + C) * 2u; voffB[i] = (unsigned)(Rb * g.ldb + C) * 2u; }
    const size_t kstep = (size_t)(BK * 2);
    const size_t hstepA = (size_t)HALF * g.lda * 2, hstepB = (size_t)HALF * g.ldb * 2;
    const size_t tstepA = 2 * hstepA, tstepB = 2 * hstepB;
    const unsigned ldsw = (unsigned)wid * 1024u;
    const int aoff = lds_byte(wr * 64 + fr, fq * 8), boff = lds_byte(wc * 32 + fr, fq * 8);
#define PG8_SA(b, h) (((b) * 2 + (h)) * HTB)
#define PG8_SB(b, h) ((4 + (b) * 2 + (h)) * HTB)
#define PG8_STAGE(bufoff, gbase, voff) do { _Pragma("unroll") for (int _i = 0; _i < 2; ++_i) \
        __builtin_amdgcn_global_load_lds((const unsigned*)((const char*)(gbase) + (voff)[_i]), (LAS unsigned*)(lds + (bufoff) + ldsw + _i * 8192), 16, 0, 0); } while (0)
#define PG8_LDA(dst, b, h) do { _Pragma("unroll") for (int m = 0; m < 4; ++m) _Pragma("unroll") for (int k = 0; k < 2; ++k) dst[m][k] = *(const LAS bf16x8*)(lds + PG8_SA(b, h) + aoff + m * 2048 + k * 1024); } while (0)
#define PG8_LDB(dst, b, h) do { _Pragma("unroll") for (int n = 0; n < 2; ++n) _Pragma("unroll") for (int k = 0; k < 2; ++k) dst[n][k] = *(const LAS bf16x8*)(lds + PG8_SB(b, h) + boff + n * 2048 + k * 1024); } while (0)
#define PG8_MMA(ai, bj, At, Bt) do { __builtin_amdgcn_s_setprio(1); _Pragma("unroll") for (int m = 0; m < 4; ++m) _Pragma("unroll") for (int n = 0; n < 2; ++n) _Pragma("unroll") for (int k = 0; k < 2; ++k) \
        acc[ai][bj][m][n] = __builtin_amdgcn_mfma_f32_16x16x32_bf16(Bt[n][k], At[m][k], acc[ai][bj][m][n], 0, 0, 0); __builtin_amdgcn_s_setprio(0); } while (0)
#define PG8_WAIT_V(n) asm volatile("s_waitcnt vmcnt(" #n ")" ::: "memory")
#define PG8_WAIT_L(n) asm volatile("s_waitcnt lgkmcnt(" #n ")" ::: "memory")
#define PG8_BAR __builtin_amdgcn_s_barrier()
#define PG8_SCHED __builtin_amdgcn_sched_barrier(0)
    Unit cur, nxt; int ui = 0;
    if (!S.next(0, cur)) return;
    f32x4 acc[2][2][4][2];
#pragma unroll
    for (int a = 0; a < 2; ++a)
#pragma unroll
        for (int b = 0; b < 2; ++b)
#pragma unroll
            for (int m = 0; m < 4; ++m)
#pragma unroll
                for (int n = 0; n < 2; ++n) acc[a][b][m][n] = (f32x4){0.f, 0.f, 0.f, 0.f};
    bf16x8 At[4][2], B0[2][2], B1[2][2];
    const char* cA = (const char*)g.A + (size_t)cur.pm * tstepA; const char* cB = (const char*)g.Bt + (size_t)cur.pn * tstepB;
    PG8_STAGE(PG8_SB(0, 0), cB, voffB); PG8_STAGE(PG8_SA(0, 0), cA, voffA); PG8_STAGE(PG8_SB(0, 1), cB + hstepB, voffB); PG8_STAGE(PG8_SA(0, 1), cA + hstepA, voffA);
    if (wr == 1) PG8_BAR;
    PG8_WAIT_V(4); PG8_BAR;
    PG8_STAGE(PG8_SB(1, 0), cB + kstep, voffB); PG8_STAGE(PG8_SA(1, 0), cA + kstep, voffA); PG8_STAGE(PG8_SB(1, 1), cB + hstepB + kstep, voffB);
    PG8_WAIT_V(6); PG8_BAR;
    for (;;) {
        const bool has_next = S.next(ui + 1, nxt);
        const char* nA = has_next ? (const char*)g.A + (size_t)nxt.pm * tstepA : cA; const char* nB = has_next ? (const char*)g.Bt + (size_t)nxt.pn * tstepB : cB;
        for (int t = 0; t < nt; t += 2) {
            const bool last = (t == nt - 2);
            const char* a1 = cA + (size_t)(t + 1) * kstep;
            const char* a2 = last ? nA : cA + (size_t)(t + 2) * kstep; const char* b2 = last ? nB : cB + (size_t)(t + 2) * kstep;
            const char* a3 = a2 + kstep; const char* b3 = b2 + kstep;
            PG8_LDB(B0, 0, 0); PG8_SCHED; PG8_LDA(At, 0, 0); PG8_STAGE(PG8_SA(1, 1), a1 + hstepA, voffA);
            PG8_WAIT_L(8); PG8_BAR; PG8_WAIT_L(0); PG8_MMA(0, 0, At, B0); PG8_BAR; PG8_SCHED;
            PG8_LDB(B1, 0, 1); PG8_STAGE(PG8_SB(0, 0), b2, voffB);
            PG8_BAR; PG8_WAIT_L(0); PG8_MMA(0, 1, At, B1); PG8_BAR;
            PG8_LDA(At, 0, 1); PG8_STAGE(PG8_SA(0, 0), a2, voffA);
            PG8_BAR; PG8_WAIT_L(0); PG8_MMA(1, 0, At, B0); PG8_BAR; PG8_SCHED;
            PG8_STAGE(PG8_SB(0, 1), b2 + hstepB, voffB);
            PG8_WAIT_V(6); PG8_BAR; PG8_MMA(1, 1, At, B1); PG8_BAR;
            PG8_LDB(B0, 1, 0); PG8_SCHED; PG8_LDA(At, 1, 0); PG8_STAGE(PG8_SA(0, 1), a2 + hstepA, voffA);
            PG8_WAIT_L(8); PG8_BAR; PG8_WAIT_L(0); PG8_MMA(0, 0, At, B0); PG8_BAR; PG8_SCHED;
            PG8_LDB(B1, 1, 1); PG8_STAGE(PG8_SB(1, 0), b3, voffB);
            PG8_BAR; PG8_WAIT_L(0); PG8_MMA(0, 1, At, B1); PG8_BAR;
            PG8_LDA(At, 1, 1); PG8_STAGE(PG8_SA(1, 0), a3, voffA);
            PG8_BAR; PG8_WAIT_L(0); PG8_MMA(1, 0, At, B0); PG8_BAR; PG8_SCHED;
            PG8_STAGE(PG8_SB(1, 1), b3 + hstepB, voffB);
            PG8_WAIT_V(6); PG8_BAR; PG8_MMA(1, 1, At, B1); PG8_BAR;
        }
        E(acc, cur, wr, wc, fr, fq);
        if (!has_next) break;
#pragma unroll
        for (int a = 0; a < 2; ++a)
#pragma unroll
            for (int b = 0; b < 2; ++b)
#pragma unroll
                for (int m = 0; m < 4; ++m)
#pragma unroll
                    for (int n = 0; n < 2; ++n) acc[a][b][m][n] = (f32x4){0.f, 0.f, 0.f, 0.f};
        cur = nxt; cA = nA; cB = nB; ++ui;
    }
    PG8_WAIT_V(0);
    if (wr == 0) PG8_BAR;
    PG8_BAR;
#undef PG8_SA
#undef PG8_SB
#undef PG8_STAGE
#undef PG8_LDA
#undef PG8_LDB
#undef PG8_MMA
#undef PG8_WAIT_V
#undef PG8_WAIT_L
#undef PG8_BAR
#undef PG8_SCHED
}
}
using pg8::Unit;
typedef const f32x4 (&AccRef)[2][2][4][2];

struct Epi1 {
    static constexpr bool PERM = true;
    bf16_t *q, *kbuf, *ks, *bg, *cu, *sga, *sgb; float* out;
    DI void operator()(AccRef acc, const Unit& u, int wr, int wc, int fr, int fq) const {
        const int pn = u.pn, rbase = u.pm * 256 + wr * 64 + fr, cl = wc * 32 + 8 * fq;
        if (pn >= 12 && pn < 20) {
            const int ch = (pn - 12) * 128 + cl;
#pragma unroll
            for (int ai = 0; ai < 2; ++ai)
#pragma unroll
                for (int m = 0; m < 4; ++m) {
                    const int row = rbase + ai * 128 + m * 16;
                    const f32x4 p0 = acc[ai][0][m][0] * acc[ai][1][m][0], p1 = acc[ai][0][m][1] * acc[ai][1][m][1];
                    *(u32x4*)(cu + (size_t)row * D + ch) = pk8(p0, p1);
                    float* dst = nullptr;
                    if (row < MP) { const int t = row & (T - 1); if (t >= T - 2) dst = out + O_CP + ((size_t)(row >> 12) * 2 + (t - (T - 2))) * D + ch; }
                    else { const int rs = row - MP, i = rs & 31; if (i >= ST - 2) dst = out + O_CS + ((size_t)(rs >> 5) * 2 + (i - (ST - 2))) * D + ch; }
                    if (dst) { *(f32x4*)dst = p0; *(f32x4*)(dst + 4) = p1; }
                }
            return;
        }
#pragma unroll
        for (int ai = 0; ai < 2; ++ai)
#pragma unroll
            for (int m = 0; m < 4; ++m) {
                const int row = rbase + ai * 128 + m * 16;
#pragma unroll
                for (int bj = 0; bj < 2; ++bj) {
                    f32x4 v0 = acc[ai][bj][m][0], v1 = acc[ai][bj][m][1];
                    if (pn < 4) { const int col = pn * 256 + bj * 128 + cl; *(u32x4*)(q + (size_t)row * D + col) = pk8(v0 * 0.125f, v1 * 0.125f); }
                    else if (pn < 8) {
                        const int col = (pn - 4) * 256 + bj * 128 + cl;
                        bf16_t* kd; float* od;
                        if (row < MP) { kd = kbuf + (size_t)row * D + col; od = out + O_KP + (size_t)row * D + col; }
                        else { const int rs = row - MP; kd = ks + ((size_t)(rs >> 5) * SKV + PAST + (rs & 31)) * D + col; od = out + O_KS + (size_t)rs * D + col; }
                        *(u32x4*)kd = pk8(v0, v1); *(f32x4*)od = v0; *(f32x4*)(od + 4) = v1;
                    }
                    else if (pn < 12) { const int col = (pn - 8) * 256 + bj * 128 + cl; *(u32x4*)(bg + (size_t)row * D + col) = pk8(v0, v1); }
                    else {
                        bf16_t* dst = (pn < 24) ? sga : sgb; const int col = ((pn - 20) & 3) * 256 + bj * 128 + cl;
#pragma unroll
                        for (int j = 0; j < 4; ++j) { v0[j] = sigmoidf_(v0[j]); v1[j] = sigmoidf_(v1[j]); }
                        *(u32x4*)(dst + (size_t)row * D + col) = pk8(v0, v1);
                    }
                }
            }
    }
};
struct Epi1V {
    static constexpr bool PERM = true;
    bf16_t *vT, *vts; float* out;
    DI void operator()(AccRef acc, const Unit& u, int wr, int wc, int fr, int fq) const {
        const int rbase = u.pm * 256 + wr * 64 + fr, cl = wc * 32 + 8 * fq;
#pragma unroll
        for (int ai = 0; ai < 2; ++ai)
#pragma unroll
            for (int m = 0; m < 4; ++m) {
                const int r = rbase + ai * 128 + m * 16;
#pragma unroll
                for (int bj = 0; bj < 2; ++bj) {
                    const int tok = u.pn * 256 + bj * 128 + cl;
                    const f32x4 v0 = acc[ai][bj][m][0], v1 = acc[ai][bj][m][1];
                    float* od;
                    if (tok < MP) { *(u32x4*)(vT + (size_t)r * MP + tok) = pk8(v0, v1); od = out + O_VP + (size_t)tok * D + r; }
                    else { const int ts = tok - MP; *(u32x4*)(vts + ((size_t)(ts >> 5) * D + r) * SKV + PAST + (ts & 31)) = pk8(v0, v1); od = out + O_VS + (size_t)ts * D + r; }
#pragma unroll
                    for (int j = 0; j < 4; ++j) { od[(size_t)j * D] = v0[j]; od[(size_t)(j + 4) * D] = v1[j]; }
                }
            }
    }
};
template <int MODE  > struct EpiAB {
    static constexpr bool PERM = true;
    const bf16_t* sg; bf16_t* tm;
    DI void operator()(AccRef acc, const Unit& u, int wr, int wc, int fr, int fq) const {
        const int rbase = u.pm * 256 + wr * 64 + fr, cb = u.pn * 256 + wc * 32 + 8 * fq;
#pragma unroll
        for (int ai = 0; ai < 2; ++ai)
#pragma unroll
            for (int m = 0; m < 4; ++m) {
                const size_t ro = (size_t)(rbase + ai * 128 + m * 16) * D;
#pragma unroll
                for (int bj = 0; bj < 2; ++bj) {
                    const size_t o = ro + cb + bj * 128;
                    const u32x4 s = *(const u32x4*)(sg + o);
                    f32x4 v0 = acc[ai][bj][m][0], v1 = acc[ai][bj][m][1];
                    v0[0] *= bflo(s.x); v0[1] *= bfhi(s.x); v0[2] *= bflo(s.y); v0[3] *= bfhi(s.y);
                    v1[0] *= bflo(s.z); v1[1] *= bfhi(s.z); v1[2] *= bflo(s.w); v1[3] *= bfhi(s.w);
                    if (MODE == 1) { const u32x4 p = *(const u32x4*)(tm + o);
                        v0[0] += bflo(p.x); v0[1] += bfhi(p.x); v0[2] += bflo(p.y); v0[3] += bfhi(p.y);
                        v1[0] += bflo(p.z); v1[1] += bfhi(p.z); v1[2] += bflo(p.w); v1[3] += bfhi(p.w); }
                    *(u32x4*)(tm + o) = pk8(v0, v1);
                }
            }
    }
};
template <int MODE  > struct EpiRes {
    static constexpr bool PERM = false;
    const float *xp, *xs, *mod; float* y;
    DI void operator()(AccRef acc, const Unit& u, int wr, int wc, int fr, int fq) const {
        const int rbase = u.pm * 256 + wr * 64 + fr, cb = u.pn * 256 + wc * 32 + 4 * fq;
#pragma unroll
        for (int ai = 0; ai < 2; ++ai)
#pragma unroll
            for (int m = 0; m < 4; ++m) {
                const int row = rbase + ai * 128 + m * 16;
                const float* gp = mod + (size_t)bidx_of(row) * NMOD + (MODE == 0 ? 2 * D : 5 * D);
                const float* src = (MODE == 1) ? y + (size_t)row * D : (row < MP ? xp + (size_t)row * D : xs + (size_t)(row - MP) * D);
                float* dst = y + (size_t)row * D;
#pragma unroll
                for (int bj = 0; bj < 2; ++bj)
#pragma unroll
                    for (int n = 0; n < 2; ++n) { const int c = cb + bj * 128 + n * 16;
                        *(f32x4*)(dst + c) = *(const f32x4*)(src + c) + *(const f32x4*)(gp + c) * acc[ai][bj][m][n]; }
            }
    }
};
struct EpiUp {
    static constexpr bool PERM = true;
    bf16_t* ug; float* out;
    DI void operator()(AccRef acc, const Unit& u, int wr, int wc, int fr, int fq) const {
        const int rbase = u.pm * 256 + wr * 64 + fr, cb = u.pn * 256 + wc * 32 + 8 * fq;
#pragma unroll
        for (int ai = 0; ai < 2; ++ai)
#pragma unroll
            for (int m = 0; m < 4; ++m) {
                const int row = rbase + ai * 128 + m * 16;
                float* dst = nullptr;
                if (u.pn < 11) {
                    if (row < MP) { const int t = row & (T - 1); if (t >= T - 2) dst = out + O_FP + ((size_t)(row >> 12) * 2 + (t - (T - 2))) * DFF; }
                    else { const int rs = row - MP, i = rs & 31; if (i >= ST - 2) dst = out + O_FS + ((size_t)(rs >> 5) * 2 + (i - (ST - 2))) * DFF; }
                }
#pragma unroll
                for (int bj = 0; bj < 2; ++bj) { const int c = cb + bj * 128;
                    *(u32x4*)(ug + (size_t)row * (2 * DFF) + c) = pk8(acc[ai][bj][m][0], acc[ai][bj][m][1]);
                    if (dst) { *(f32x4*)(dst + c) = acc[ai][bj][m][0]; *(f32x4*)(dst + c + 4) = acc[ai][bj][m][1]; } }
            }
    }
};

DI void tr_tile(const float* src, int lds_, bf16_t* dst, int ldd, LAS float* sm, int tid) {
    { const int c4 = tid & 15;
#pragma unroll
      for (int i = 0; i < 2; ++i) { const int kk = (tid >> 4) + 32 * i; const f32x4 v = *(const f32x4*)(src + (size_t)kk * lds_ + c4 * 4);
#pragma unroll
          for (int j = 0; j < 4; ++j) sm[(c4 * 4 + j) * 65 + kk] = v[j]; } }
    __syncthreads();
    { const int n = tid >> 3, k8 = (tid & 7) * 8; const LAS float* s = sm + n * 65 + k8;
      u32x4 w; w.x = pk2(s[0], s[1]); w.y = pk2(s[2], s[3]); w.z = pk2(s[4], s[5]); w.w = pk2(s[6], s[7]);
      *(u32x4*)(dst + (size_t)n * ldd + k8) = w; }
    __syncthreads();
}
DI int win_srccol(int n) {
    if (n < 2048) return n;
    if (n < 3072) return n + 1024;
    if (n < 5120) { const int j = (n - 3072) >> 8, r = (n - 3072) & 255; return r < 128 ? 4096 + 128 * j + r : 5120 + 128 * j + (r - 128); }
    return n + 1024;
}

struct Params {
    const float *x_prompt, *x_sample, *cache_k, *cache_v, *state_conv, *state_ffn, *c_prompt, *c_sample, *w_ada, *b_ada, *g_norm1, *w_in, *w_conv, *b_conv,
                *w_branch_a, *w_branch_b, *w_out, *g_norm2, *w_up, *w_fconv, *b_fconv, *w_down, *g_final;
    float* out; unsigned char* ws;
};

DI void phase_prep(const Params& p, LAS unsigned char* lds, int tid) {
    LAS float* sm = (LAS float*)lds;
    unsigned char* ws = p.ws;
    const int G = gridDim.x, bx = blockIdx.x;
    constexpr int T_WIN = (N1 / 64) * 16, T_WV = 256, T_SQ = 256, T_WUP = (2 * DFF / 64) * 16, T_WDN = 16 * (DFF / 64), T_CV = SB * 256;
    constexpr int E1 = T_WIN, E2 = E1 + T_WV, E3 = E2 + T_SQ, E4 = E3 + T_SQ, E5 = E4 + T_SQ, E6 = E5 + T_WUP, E7 = E6 + T_WDN, E8 = E7 + T_CV;
    for (int t = bx; t < E8; t += G) {
        if (t < E1) { const int nt = t >> 4, kt = t & 15; tr_tile(p.w_in + (size_t)kt * 64 * 8192 + win_srccol(nt * 64), 8192, (bf16_t*)(ws + WS_WIN) + (size_t)nt * 64 * D + kt * 64, D, sm, tid); }
        else if (t < E2) { const int q = t - E1, nt = q >> 4, kt = q & 15; tr_tile(p.w_in + (size_t)kt * 64 * 8192 + 2048 + nt * 64, 8192, (bf16_t*)(ws + WS_WV) + (size_t)nt * 64 * D + kt * 64, D, sm, tid); }
        else if (t < E5) { const int w = (t - E2) >> 8, q = (t - E2) & 255, nt = q >> 4, kt = q & 15;
            const float* src = w == 0 ? p.w_branch_a : (w == 1 ? p.w_branch_b : p.w_out); const size_t off = w == 0 ? WS_WA : (w == 1 ? WS_WB : WS_WO);
            tr_tile(src + (size_t)kt * 64 * D + nt * 64, D, (bf16_t*)(ws + off) + (size_t)nt * 64 * D + kt * 64, D, sm, tid); }
        else if (t < E6) { const int q = t - E5, nt = q >> 4, kt = q & 15; tr_tile(p.w_up + (size_t)kt * 64 * (2 * DFF) + nt * 64, 2 * DFF, (bf16_t*)(ws + WS_WUP) + (size_t)nt * 64 * D + kt * 64, D, sm, tid); }
        else if (t < E7) { const int q = t - E6, nt = q / (DFF / 64), kt = q % (DFF / 64); tr_tile(p.w_down + (size_t)kt * 64 * D + nt * 64, D, (bf16_t*)(ws + WS_WDN) + (size_t)nt * 64 * DFF + kt * 64, DFF, sm, tid); }
        else { const int q = t - E7, b = q >> 8, nt = (q >> 4) & 15, kt = q & 15;
            tr_tile(p.cache_v + (size_t)b * PAST * D + (size_t)kt * 64 * D + nt * 64, D, (bf16_t*)(ws + WS_VTS) + ((size_t)b * D + nt * 64) * SKV + kt * 64, SKV, sm, tid); }
    }
    { bf16_t* ks = (bf16_t*)(ws + WS_KS);
      for (size_t i = (size_t)bx * 512 + tid; i < (size_t)SB * PAST * D / 8; i += (size_t)G * 512) {
          const size_t e = i * 8; const int b = (int)(e / ((size_t)PAST * D)); const size_t r = e % ((size_t)PAST * D);
          const f32x4 a = *(const f32x4*)(p.cache_k + e), c = *(const f32x4*)(p.cache_k + e + 4);
          *(u32x4*)(ks + (size_t)b * SKV * D + r) = pk8(a, c); } }
    for (int job = bx; job < NMOD / 32; job += G) {
        __syncthreads();
        for (int i = tid; i < 24 * D; i += 512) { const int r = i >> 10, k = i & 1023; const float c = r < 16 ? p.c_prompt[r * D + k] : p.c_sample[(r - 16) * D + k]; sm[i] = c / (1.0f + __expf(-c)); }
        __syncthreads();
        const int n = tid & 31, kq = tid >> 5, col = job * 32 + n;
        float a[24];
#pragma unroll
        for (int r = 0; r < 24; ++r) a[r] = 0.f;
        for (int k = kq * 64; k < kq * 64 + 64; ++k) { const float w = p.w_ada[(size_t)k * NMOD + col];
#pragma unroll
            for (int r = 0; r < 24; ++r) a[r] += sm[r * D + k] * w; }
        __syncthreads();
#pragma unroll
        for (int r = 0; r < 24; ++r) sm[(kq * 24 + r) * 32 + n] = a[r];
        __syncthreads();
        for (int i = tid; i < 24 * 32; i += 512) { const int r = i >> 5, nn = i & 31; float s = p.b_ada[job * 32 + nn];
            for (int q = 0; q < 16; ++q) s += sm[(q * 24 + r) * 32 + nn];
            ((float*)(ws + WS_MOD))[(size_t)r * NMOD + job * 32 + nn] = s; }
    }
    __syncthreads();
}

DI void phase_norm_mod(const float* srcP, const float* srcS, const float* g, const float* mod, int shift_off, bf16_t* dst, int gw, int nw, int lane) {
    f32x4 gv[4];
#pragma unroll
    for (int i = 0; i < 4; ++i) gv[i] = *(const f32x4*)(g + lane * 4 + 256 * i);
    for (int row = gw; row < M; row += nw) {
        const float* s = row < MP ? srcP + (size_t)row * D : srcS + (size_t)(row - MP) * D;
        f32x4 v[4]; float ss = 0.f;
#pragma unroll
        for (int i = 0; i < 4; ++i) { v[i] = *(const f32x4*)(s + lane * 4 + 256 * i); ss += v[i][0] * v[i][0] + v[i][1] * v[i][1] + v[i][2] * v[i][2] + v[i][3] * v[i][3]; }
#pragma unroll
        for (int o = 32; o >= 1; o >>= 1) ss += __shfl_xor(ss, o);
        const float rstd = rsqrtf(ss * (1.0f / D) + 1e-6f);
        const float* mp = mod + (size_t)bidx_of(row) * NMOD + shift_off;
#pragma unroll
        for (int i = 0; i < 4; ++i) { const int c = lane * 4 + 256 * i; const f32x4 sh = *(const f32x4*)(mp + c), sc = *(const f32x4*)(mp + D + c);
            const f32x4 h = v[i] * rstd * gv[i] * (sc + 1.0f) + sh;
            u32x2 w; w.x = pk2(h[0], h[1]); w.y = pk2(h[2], h[3]); *(u32x2*)(dst + (size_t)row * D + c) = w; }
    }
}
DI void phase_final_norm(float* y, const float* g, int gw, int nw, int lane) {
    f32x4 gv[4];
#pragma unroll
    for (int i = 0; i < 4; ++i) gv[i] = *(const f32x4*)(g + lane * 4 + 256 * i);
    for (int row = gw; row < M; row += nw) {
        float* s = y + (size_t)row * D; f32x4 v[4]; float ss = 0.f;
#pragma unroll
        for (int i = 0; i < 4; ++i) { v[i] = *(const f32x4*)(s + lane * 4 + 256 * i); ss += v[i][0] * v[i][0] + v[i][1] * v[i][1] + v[i][2] * v[i][2] + v[i][3] * v[i][3]; }
#pragma unroll
        for (int o = 32; o >= 1; o >>= 1) ss += __shfl_xor(ss, o);
        const float rstd = rsqrtf(ss * (1.0f / D) + 1e-6f);
#pragma unroll
        for (int i = 0; i < 4; ++i) *(f32x4*)(s + lane * 4 + 256 * i) = v[i] * rstd * gv[i];
    }
}

DI void phase_ob(const Params& p, bf16_t* bg, const bf16_t* cu, int gw, int nw, int lane) {
    for (int item = gw; item < (M / 16) * 2; item += nw) {
        const int half = item & 1, row0 = (item >> 1) * 16, ch = half * 512 + lane * 8;
        float w0[8], w1[8], w2[8], bb[8], p2[8], p1[8];
#pragma unroll
        for (int j = 0; j < 8; ++j) { w0[j] = p.w_conv[ch + j]; w1[j] = p.w_conv[D + ch + j]; w2[j] = p.w_conv[2 * D + ch + j]; bb[j] = p.b_conv[ch + j]; }
        const bool start = row0 < MP ? ((row0 & (T - 1)) == 0) : (((row0 - MP) & 31) == 0);
        if (start) {
            if (row0 < MP) {
#pragma unroll
                for (int j = 0; j < 8; ++j) { p2[j] = 0.f; p1[j] = 0.f; } }
            else { const float* sc = p.state_conv + (size_t)((row0 - MP) >> 5) * 2 * D + ch;
#pragma unroll
                for (int j = 0; j < 8; ++j) { p2[j] = sc[j]; p1[j] = sc[D + j]; } }
        } else {
            const u32x4 a = *(const u32x4*)(cu + (size_t)(row0 - 2) * D + ch), b = *(const u32x4*)(cu + (size_t)(row0 - 1) * D + ch);
            p2[0] = bflo(a.x); p2[1] = bfhi(a.x); p2[2] = bflo(a.y); p2[3] = bfhi(a.y); p2[4] = bflo(a.z); p2[5] = bfhi(a.z); p2[6] = bflo(a.w); p2[7] = bfhi(a.w);
            p1[0] = bflo(b.x); p1[1] = bfhi(b.x); p1[2] = bflo(b.y); p1[3] = bfhi(b.y); p1[4] = bflo(b.z); p1[5] = bfhi(b.z); p1[6] = bflo(b.w); p1[7] = bfhi(b.w);
        }
        for (int r = 0; r < 16; ++r) {
            const size_t o = (size_t)(row0 + r) * D + ch;
            const u32x4 c = *(const u32x4*)(cu + o), gq = *(const u32x4*)(bg + o);
            float cur[8] = {bflo(c.x), bfhi(c.x), bflo(c.y), bfhi(c.y), bflo(c.z), bfhi(c.z), bflo(c.w), bfhi(c.w)};
            float gg[8] = {bflo(gq.x), bfhi(gq.x), bflo(gq.y), bfhi(gq.y), bflo(gq.z), bfhi(gq.z), bflo(gq.w), bfhi(gq.w)};
            float y[8];
#pragma unroll
            for (int j = 0; j < 8; ++j) { y[j] = gg[j] * (w0[j] * p2[j] + w1[j] * p1[j] + w2[j] * cur[j] + bb[j]); p2[j] = p1[j]; p1[j] = cur[j]; }
            u32x4 w; w.x = pk2(y[0], y[1]); w.y = pk2(y[2], y[3]); w.z = pk2(y[4], y[5]); w.w = pk2(y[6], y[7]);
            *(u32x4*)(bg + o) = w;
        }
    }
}
DI void phase_act(const Params& p, bf16_t* ug, int gw, int nw, int lane) {
    for (int item = gw; item < (M / 16) * 11; item += nw) {
        const int slab = item % 11, row0 = (item / 11) * 16, ch = slab * 256 + lane * 4;
        float w0[4], w1[4], w2[4], bb[4], p2[4], p1[4];
#pragma unroll
        for (int j = 0; j < 4; ++j) { w0[j] = p.w_fconv[ch + j]; w1[j] = p.w_fconv[DFF + ch + j]; w2[j] = p.w_fconv[2 * DFF + ch + j]; bb[j] = p.b_fconv[ch + j]; }
        const bool start = row0 < MP ? ((row0 & (T - 1)) == 0) : (((row0 - MP) & 31) == 0);
        if (start) {
            if (row0 < MP) {
#pragma unroll
                for (int j = 0; j < 4; ++j) { p2[j] = 0.f; p1[j] = 0.f; } }
            else { const float* sc = p.state_ffn + (size_t)((row0 - MP) >> 5) * 2 * DFF + ch;
#pragma unroll
                for (int j = 0; j < 4; ++j) { p2[j] = sc[j]; p1[j] = sc[DFF + j]; } }
        } else {
            const u32x2 a = *(const u32x2*)(ug + (size_t)(row0 - 2) * (2 * DFF) + ch), b = *(const u32x2*)(ug + (size_t)(row0 - 1) * (2 * DFF) + ch);
            p2[0] = bflo(a.x); p2[1] = bfhi(a.x); p2[2] = bflo(a.y); p2[3] = bfhi(a.y);
            p1[0] = bflo(b.x); p1[1] = bfhi(b.x); p1[2] = bflo(b.y); p1[3] = bfhi(b.y);
        }
        for (int r = 0; r < 16; ++r) {
            const size_t o = (size_t)(row0 + r) * (2 * DFF) + ch;
            const u32x2 c = *(const u32x2*)(ug + o), gq = *(const u32x2*)(ug + o + DFF);
            float cur[4] = {bflo(c.x), bfhi(c.x), bflo(c.y), bfhi(c.y)};
            float gg[4] = {bflo(gq.x), bfhi(gq.x), bflo(gq.y), bfhi(gq.y)};
            float y[4];
#pragma unroll
            for (int j = 0; j < 4; ++j) { const float uc = w0[j] * p2[j] + w1[j] * p1[j] + w2[j] * cur[j] + bb[j]; y[j] = gg[j] * uc / (1.0f + __expf(-uc)); p2[j] = p1[j]; p1[j] = cur[j]; }
            u32x2 w; w.x = pk2(y[0], y[1]); w.y = pk2(y[2], y[3]);
            *(u32x2*)(ug + o + DFF) = w;
        }
    }
}

#define MFMA32(a, b, c) __builtin_amdgcn_mfma_f32_32x32x16_bf16((a), (b), (c), 0, 0, 0)
DI void phase_attn(bf16_t* qo, const bf16_t* kbuf, const bf16_t* vT, const bf16_t* ks, const bf16_t* vts, LAS unsigned char* lds, int wid, int gw, int nw, int lane) {
    const int hf = lane >> 5, tl = lane & 31;
    LAS unsigned char* myl = lds + wid * (32 * 144);
    constexpr int NITEM = NB * NH * (T / 32) + SB * NH;
    for (int item = gw; item < NITEM; item += nw) {
        int qt, h, qrow0, ldv; const bf16_t *K, *VT;
        if (item < NB * NH * (T / 32)) { qt = item & 127; h = (item >> 7) & 15; const int b = item >> 11; qrow0 = b * T + qt * 32;
            K = kbuf + (size_t)(b * T) * D + h * HD; VT = vT + (size_t)(h * HD) * MP + (size_t)b * T; ldv = MP; }
        else { const int s = item - NB * NH * (T / 32); h = s & 15; const int b = s >> 4; qt = PAST / 32; qrow0 = MP + b * ST;
            K = ks + (size_t)(b * SKV) * D + h * HD; VT = vts + (size_t)(b * D + h * HD) * SKV; ldv = SKV; }
        bf16x8 qf[4];
        { const bf16_t* qp = qo + (size_t)(qrow0 + tl) * D + h * HD + 8 * hf;
#pragma unroll
          for (int s = 0; s < 4; ++s) qf[s] = *(const bf16x8*)(qp + 16 * s); }
        f32x16 O0, O1;
#pragma unroll
        for (int e = 0; e < 16; ++e) { O0[e] = 0.f; O1[e] = 0.f; }
        float carry = 0.f;
        for (int kb = qt; kb >= 0; --kb) {
            const bf16_t* kp = K + (size_t)(kb * 32 + tl) * D + 8 * hf;
            bf16x8 kf[4];
#pragma unroll
            for (int s = 0; s < 4; ++s) kf[s] = *(const bf16x8*)(kp + 16 * s);
            s16x4 vr[2][2][2];
#pragma unroll
            for (int dt = 0; dt < 2; ++dt) { const bf16_t* vp = VT + (size_t)(32 * dt + tl) * ldv + kb * 32 + 4 * hf;
#pragma unroll
                for (int s = 0; s < 2; ++s) { vr[dt][s][0] = *(const s16x4*)(vp + 16 * s); vr[dt][s][1] = *(const s16x4*)(vp + 16 * s + 8); } }
            f32x16 z;
#pragma unroll
            for (int e = 0; e < 16; ++e) z[e] = 0.f;
#pragma unroll
            for (int s = 0; s < 4; ++s) z = MFMA32(kf[s], qf[s], z);
            const bool diag = (kb == qt);
            float L[16];
#pragma unroll
            for (int e = 0; e < 16; ++e) { const float zz = z[e]; const float ex = __expf(-fabsf(zz)); float l = -(fmaxf(zz, 0.f) + __logf(1.0f + ex));
                if (diag) { const int key = 8 * (e >> 2) + 4 * hf + (e & 3); if (key >= tl) l = 0.f; }
                L[e] = l; }
            float Gs[4], Gp[4];
#pragma unroll
            for (int g = 0; g < 4; ++g) { Gs[g] = (L[4 * g] + L[4 * g + 1]) + (L[4 * g + 2] + L[4 * g + 3]); Gp[g] = __shfl_xor(Gs[g], 32); }
            float Tt[5]; Tt[4] = 0.f;
#pragma unroll
            for (int g = 3; g >= 0; --g) Tt[g] = Tt[g + 1] + (Gs[g] + Gp[g]);
            float a[16];
#pragma unroll
            for (int g = 0; g < 4; ++g) {
                const float s3 = Tt[g + 1] + (hf == 0 ? Gp[g] : 0.f) + carry;
                const float s2 = s3 + L[4 * g + 3], s1 = s2 + L[4 * g + 2], s0 = s1 + L[4 * g + 1];
                a[4 * g + 3] = __expf(z[4 * g + 3] + L[4 * g + 3] + s3); a[4 * g + 2] = __expf(z[4 * g + 2] + L[4 * g + 2] + s2);
                a[4 * g + 1] = __expf(z[4 * g + 1] + L[4 * g + 1] + s1); a[4 * g] = __expf(z[4 * g] + L[4 * g] + s0);
            }
            if (diag) {
#pragma unroll
                for (int e = 0; e < 16; ++e) { const int key = 8 * (e >> 2) + 4 * hf + (e & 3); if (key >= tl) a[e] = 0.f; } }
            carry += Tt[0];
#pragma unroll
            for (int s = 0; s < 2; ++s) {
                u32x4 aw; aw.x = pk2(a[8 * s], a[8 * s + 1]); aw.y = pk2(a[8 * s + 2], a[8 * s + 3]); aw.z = pk2(a[8 * s + 4], a[8 * s + 5]); aw.w = pk2(a[8 * s + 6], a[8 * s + 7]);
                const bf16x8 af = __builtin_bit_cast(bf16x8, aw);
                bf16x8 v0, v1;
#pragma unroll
                for (int j = 0; j < 4; ++j) { v0[j] = vr[0][s][0][j]; v0[4 + j] = vr[0][s][1][j]; v1[j] = vr[1][s][0][j]; v1[4 + j] = vr[1][s][1][j]; }
                O0 = MFMA32(v0, af, O0); O1 = MFMA32(v1, af, O1);
            }
#ifndef NO_EARLY_EXIT
            if (__all(carry < -120.0f)) break;
#endif
        }
#pragma unroll
        for (int g = 0; g < 4; ++g) {
            u32x2 w0; w0.x = pk2(O0[4 * g], O0[4 * g + 1]); w0.y = pk2(O0[4 * g + 2], O0[4 * g + 3]);
            u32x2 w1; w1.x = pk2(O1[4 * g], O1[4 * g + 1]); w1.y = pk2(O1[4 * g + 2], O1[4 * g + 3]);
            *(LAS u32x2*)(myl + tl * 144 + (8 * g + 4 * hf) * 2) = w0;
            *(LAS u32x2*)(myl + tl * 144 + (32 + 8 * g + 4 * hf) * 2) = w1;
        }
        asm volatile("s_waitcnt lgkmcnt(0)" ::: "memory");
#pragma unroll
        for (int it = 0; it < 4; ++it) { const int chunk = it * 64 + lane, row = chunk >> 3, c16 = chunk & 7;
            const u32x4 w = *(const LAS u32x4*)(myl + row * 144 + c16 * 16);
            *(u32x4*)(qo + (size_t)(qrow0 + row) * D + h * HD + c16 * 8) = w; }
        asm volatile("s_waitcnt lgkmcnt(0)" ::: "memory");
    }
}

__global__ void __launch_bounds__(512, 2) fwd_megakernel(Params p) {
    extern __shared__ __attribute__((aligned(16))) unsigned char smem[];
    LAS unsigned char* lds = (LAS unsigned char*)smem;
    cg::grid_group grid = cg::this_grid();
    const int tid = threadIdx.x, lane = tid & 63, wid = __builtin_amdgcn_readfirstlane(tid >> 6);
    const int G = gridDim.x, bx = blockIdx.x, gw = bx * 8 + wid, nw = G * 8;
    unsigned char* ws = p.ws;
    bf16_t* Win = (bf16_t*)(ws + WS_WIN); bf16_t* Wv = (bf16_t*)(ws + WS_WV); bf16_t* Wa = (bf16_t*)(ws + WS_WA); bf16_t* Wb = (bf16_t*)(ws + WS_WB);
    bf16_t* Wo = (bf16_t*)(ws + WS_WO); bf16_t* Wup = (bf16_t*)(ws + WS_WUP); bf16_t* Wdn = (bf16_t*)(ws + WS_WDN);
    float* mod = (float*)(ws + WS_MOD); bf16_t* ks = (bf16_t*)(ws + WS_KS); bf16_t* vts = (bf16_t*)(ws + WS_VTS);
    bf16_t* slot0 = (bf16_t*)(ws + WS_SLOT0);
    bf16_t* hbuf = (bf16_t*)(ws + WS_BIG);
    bf16_t* kbuf = (bf16_t*)(ws + WS_BIG + U); bf16_t* vT = (bf16_t*)(ws + WS_BIG + 2 * U);
    bf16_t* bg = (bf16_t*)(ws + WS_BIG + 3 * U); bf16_t* cu = (bf16_t*)(ws + WS_BIG + 4 * U);
    bf16_t* ug = (bf16_t*)(ws + WS_BIG);
    bf16_t* sga = (bf16_t*)p.out; bf16_t* sgb = (bf16_t*)((unsigned char*)p.out + U);
    float* y = p.out + O_Y;

    phase_prep(p, lds, tid);
    grid.sync();
    phase_norm_mod(p.x_prompt, p.x_sample, p.g_norm1, mod, 0, hbuf, gw, nw, lane);
    grid.sync();
    { pg8::Gemm g{hbuf, Win, M, N1, D, D, D}; pg8::StaticOrder S; S.init(M, N1, G, bx);
      Epi1 E{slot0, kbuf, ks, bg, cu, sga, sgb, p.out}; pg8::gemm_phase<Epi1>(lds, g, S, E); }
    { pg8::Gemm g{Wv, hbuf, D, M, D, D, D}; pg8::StaticOrder S; S.init(D, M, G, bx);
      Epi1V E{vT, vts, p.out}; pg8::gemm_phase<Epi1V>(lds, g, S, E); }
    grid.sync();
    phase_attn(slot0, kbuf, vT, ks, vts, lds, wid, gw, nw, lane);
    phase_ob(p, bg, cu, gw, nw, lane);
    grid.sync();
    { pg8::Gemm g{slot0, Wa, M, D, D, D, D}; pg8::StaticOrder S; S.init(M, D, G, bx); EpiAB<0> E{sga, hbuf}; pg8::gemm_phase<EpiAB<0>>(lds, g, S, E); }
    { pg8::Gemm g{bg, Wb, M, D, D, D, D}; pg8::StaticOrder S; S.init(M, D, G, bx); EpiAB<1> E{sgb, hbuf}; pg8::gemm_phase<EpiAB<1>>(lds, g, S, E); }
    grid.sync();
    { pg8::Gemm g{hbuf, Wo, M, D, D, D, D}; pg8::StaticOrder S; S.init(M, D, G, bx); EpiRes<0> E{p.x_prompt, p.x_sample, mod, y}; pg8::gemm_phase<EpiRes<0>>(lds, g, S, E); }
    grid.sync();
    phase_norm_mod(y, y + (size_t)MP * D, p.g_norm2, mod, 3 * D, slot0, gw, nw, lane);
    grid.sync();
    { pg8::Gemm g{slot0, Wup, M, 2 * DFF, D, D, D}; pg8::StaticOrder S; S.init(M, 2 * DFF, G, bx); EpiUp E{ug, p.out}; pg8::gemm_phase<EpiUp>(lds, g, S, E); }
    grid.sync();
    phase_act(p, ug, gw, nw, lane);
    grid.sync();
    { pg8::Gemm g{ug + DFF, Wdn, M, D, DFF, 2 * DFF, DFF}; pg8::StaticOrder S; S.init(M, D, G, bx); EpiRes<1> E{nullptr, nullptr, mod, y}; pg8::gemm_phase<EpiRes<1>>(lds, g, S, E); }
    grid.sync();
    phase_final_norm(y, p.g_final, gw, nw, lane);
}

extern "C" void kernel_launch(void* const* d_in, const int* in_sizes, int n_in, void* d_out, int out_size, void* d_ws, size_t ws_size, hipStream_t stream) {
    static int grid_blocks = 0;
    if (grid_blocks == 0) {
        if (n_in != 23 || (size_t)out_size != O_END || ws_size < WS_END) { fprintf(stderr, "kernel_launch: unexpected shapes: n_in %d out %d ws %zu (need %zu)\n", n_in, out_size, ws_size, (size_t)WS_END); grid_blocks = -1; return; }
        int dev = 0, cus = 0, per_cu = 0;
        hipGetDevice(&dev);
        hipDeviceGetAttribute(&cus, hipDeviceAttributeMultiprocessorCount, dev);
        if (hipFuncSetAttribute((const void*)fwd_megakernel, hipFuncAttributeMaxDynamicSharedMemorySize, LDS_BYTES) != hipSuccess) { fprintf(stderr, "kernel_launch: hipFuncSetAttribute failed\n"); grid_blocks = -1; return; }
        hipOccupancyMaxActiveBlocksPerMultiprocessor(&per_cu, (const void*)fwd_megakernel, 512, LDS_BYTES);
        if (per_cu < 1) { fprintf(stderr, "kernel_launch: occupancy query says 0 blocks per CU\n"); per_cu = 1; }
        grid_blocks = cus * 1;
        (void)hipGetLastError();
    }
    if (grid_blocks < 0) return;
    Params p{};
    const float** pp = (const float**)&p;
    for (int i = 0; i < 23; ++i) pp[i] = (const float*)d_in[i];
    p.out = (float*)d_out; p.ws = (unsigned char*)d_ws;
    void* args[] = {&p};
    hipError_t e = hipLaunchCooperativeKernel((const void*)fwd_megakernel, dim3(grid_blocks), dim3(512), args, LDS_BYTES, stream);
    if (e != hipSuccess) fprintf(stderr, "cooperative launch failed: %s (grid %d)\n", hipGetErrorString(e), grid_blocks);
}
```

```cpp
#define NO_STAGGER 1
#include <hip/hip_runtime.h>
#include <hip/hip_cooperative_groups.h>
#include <cstdio>
namespace cg = cooperative_groups;

#define LAS __attribute__((address_space(3)))
#define DI __device__ __forceinline__
typedef unsigned short bf16_t;
typedef short bf16x8 __attribute__((ext_vector_type(8)));
typedef short s16x4 __attribute__((ext_vector_type(4)));
typedef float f32x2 __attribute__((ext_vector_type(2)));
typedef float f32x4 __attribute__((ext_vector_type(4)));
typedef float f32x16 __attribute__((ext_vector_type(16)));
typedef unsigned u32x2 __attribute__((ext_vector_type(2)));
typedef unsigned u32x4 __attribute__((ext_vector_type(4)));
typedef __bf16 bf2_t __attribute__((ext_vector_type(2)));

constexpr int D = 1024, NB = 16, T = 4096, MP = NB * T, SB = 8, ST = 32, MS = SB * ST, M = MP + MS;
constexpr int PAST = 1024, SKV = PAST + ST, DFF = 2816, NH = 16, HD = 64, NMOD = 6 * D;
constexpr int N1 = 7168;
constexpr size_t O_Y = 0, O_KP = 67371008, O_VP = 134479872, O_CP = 201588736, O_FP = 201621504, O_KS = 201711616,
                 O_VS = 201973760, O_CS = 202235904, O_FS = 202252288, O_END = 202297344;
constexpr size_t U = (size_t)M * D * 2;
constexpr size_t WS_WIN = 0, WS_WV = WS_WIN + (size_t)N1 * D * 2, WS_WA = WS_WV + (size_t)D * D * 2, WS_WB = WS_WA + (size_t)D * D * 2,
                 WS_WO = WS_WB + (size_t)D * D * 2, WS_WUP = WS_WO + (size_t)D * D * 2, WS_WDN = WS_WUP + (size_t)2 * DFF * D * 2,
                 WS_MOD = WS_WDN + (size_t)D * DFF * 2, WS_KS = WS_MOD + (size_t)24 * NMOD * 4, WS_VTS = WS_KS + (size_t)SB * SKV * D * 2,
                 WS_SLOT0 = WS_VTS + (size_t)SB * D * SKV * 2, WS_BIG = WS_SLOT0 + U,
                 WS_ACT = WS_BIG,
                 WS_HUP = WS_ACT + (size_t)M * DFF * 2, WS_HGT = WS_HUP + (size_t)(MP / 64) * 2 * DFF * 2, WS_TUP = WS_HGT + (size_t)(MP / 64) * 2 * DFF * 2,
                 WS_UGS = WS_TUP + (size_t)(MP / 64) * 2 * DFF * 2, WS_ACT_END = WS_UGS + (size_t)MS * 2 * DFF * 2,
                 WS_END = (WS_BIG + 5 * U > WS_ACT_END) ? WS_BIG + 5 * U : WS_ACT_END;
constexpr int LDS_BYTES = 131072;

DI unsigned pk2(float lo, float hi) { f32x2 v = {lo, hi}; return __builtin_bit_cast(unsigned, __builtin_convertvector(v, bf2_t)); }
DI float bflo(unsigned w) { return __uint_as_float(w << 16); }
DI float bfhi(unsigned w) { return __uint_as_float(w & 0xffff0000u); }
DI u32x4 pk8(f32x4 a, f32x4 b) { u32x4 w; w.x = pk2(a[0], a[1]); w.y = pk2(a[2], a[3]); w.z = pk2(b[0], b[1]); w.w = pk2(b[2], b[3]); return w; }
DI float sigmoidf_(float x) { return 1.0f / (1.0f + __expf(-x)); }
DI int tid_() { int t = threadIdx.x; asm volatile("" : "+v"(t)); return t; }
DI int bidx_of(int row) { return row < MP ? (row >> 12) : 16 + ((row - MP) >> 5); }

namespace pg8 {
constexpr int BM = 256, BK = 64, HALF = 128, HTB = HALF * BK * 2, STAGE_BYTES = 8 * HTB, NXCD = 8, WGM = 8;
DI int lds_byte(int r, int c) { const int st = (r >> 4) * 2 + (c >> 5), rr = r & 15, cc = c & 31, ob = rr * 64 + cc * 2; return st * 1024 + (ob ^ (((ob >> 9) & 1) << 5)); }
DI void stage_rc(int b, int& R, int& C) { const int st = b / 1024, sb = b % 1024, swz = sb ^ (((sb >> 9) & 1) << 5); R = (st >> 1) * 16 + swz / 64; C = (st & 1) * 32 + (swz % 64) / 2; }
DI int perm32(int rho) { const int n = rho >> 4, i = rho & 15; return 8 * (i >> 2) + 4 * n + (i & 3); }
struct Unit { int pm, pn; };
struct Gemm { const bf16_t* A; const bf16_t* Bt; int M, N, K, lda, ldb; };
struct StaticOrder {
    int nM, nN, nwg, G, c;
    DI void init(int M_, int N_, int G_, int c_) { nM = M_ / BM; nN = N_ / BM; nwg = nM * nN; G = G_; c = c_; }
    DI bool next(int i, Unit& u) const {
        const long L = (long)i * G + c; if (L >= nwg) return false;
        int wgid = (int)L; { const int q = nwg / NXCD, r = nwg % NXCD, xcd = wgid % NXCD, off = wgid / NXCD; wgid = (xcd < r ? xcd * (q + 1) : r * (q + 1) + (xcd - r) * q) + off; }
        const int nig = WGM * nN, gid = wgid / nig, fm = gid * WGM, gsz = (nM - fm) < WGM ? (nM - fm) : WGM;
        u.pm = fm + ((wgid % nig) % gsz); u.pn = (wgid % nig) / gsz; return true;
    }
};

template <class Epi>
DI void gemm_phase(LAS unsigned char* lds, const Gemm g, const StaticOrder& S, const Epi& E) {
    const int tid = tid_(), wid = __builtin_amdgcn_readfirstlane(tid >> 6), lane = tid & 63, wr = wid >> 2, wc = wid & 3, fr = lane & 15, fq = lane >> 4;
    const int K = g.K, nt = K / BK;
    unsigned voffA[2], voffB[2];
#pragma unroll
    for (int i = 0; i < 2; ++i) { int R, C; stage_rc(tid * 16 + i * 8192, R, C); const int Rb = Epi::PERM ? ((R & ~31) + perm32(R & 31)) : R;
        voffA[i] = (unsigned)(R * g.lda + C) * 2u; voffB[i] = (unsigned)(Rb * g.ldb + C) * 2u; }
    const size_t kstep = (size_t)(BK * 2);
    const size_t hstepA = (size_t)HALF * g.lda * 2, hstepB = (size_t)HALF * g.ldb * 2;
    const size_t tstepA = 2 * hstepA, tstepB = 2 * hstepB;
    const unsigned ldsw = (unsigned)wid * 1024u;
    const int aoff = lds_byte(wr * 64 + fr, fq * 8), boff = lds_byte(wc * 32 + fr, fq * 8);
#define PG8_SA(b, h) (((b) * 2 + (h)) * HTB)
#define PG8_SB(b, h) ((4 + (b) * 2 + (h)) * HTB)
#define PG8_STAGE(bufoff, gbase, voff) do { _Pragma("unroll") for (int _i = 0; _i < 2; ++_i) \
        __builtin_amdgcn_global_load_lds((const unsigned*)((const char*)(gbase) + (voff)[_i]), (LAS unsigned*)(lds + (bufoff) + ldsw + _i * 8192), 16, 0, 0); } while (0)
#define PG8_LDA(dst, b, h) do { _Pragma("unroll") for (int m = 0; m < 4; ++m) _Pragma("unroll") for (int k = 0; k < 2; ++k) dst[m][k] = *(const LAS bf16x8*)(lds + PG8_SA(b, h) + aoff + m * 2048 + k * 1024); } while (0)
#define PG8_LDB(dst, b, h) do { _Pragma("unroll") for (int n = 0; n < 2; ++n) _Pragma("unroll") for (int k = 0; k < 2; ++k) dst[n][k] = *(const LAS bf16x8*)(lds + PG8_SB(b, h) + boff + n * 2048 + k * 1024); } while (0)
#define PG8_MMA(ai, bj, At, Bt) do { __builtin_amdgcn_s_setprio(1); _Pragma("unroll") for (int m = 0; m < 4; ++m) _Pragma("unroll") for (int n = 0; n < 2; ++n) _Pragma("unroll") for (int k = 0; k < 2; ++k) \
        acc[ai][bj][m][n] = __builtin_amdgcn_mfma_f32_16x16x32_bf16(Bt[n][k], At[m][k], acc[ai][bj][m][n], 0, 0, 0); __builtin_amdgcn_s_setprio(0); } while (0)
#define PG8_WAIT_V(n) asm volatile("s_waitcnt vmcnt(" #n ")" ::: "memory")
#define PG8_WAIT_L(n) asm volatile("s_waitcnt lgkmcnt(" #n ")" ::: "memory")
#define PG8_BAR __builtin_amdgcn_s_barrier()
#define PG8_SCHED __builtin_amdgcn_sched_barrier(0)
    Unit cur, nxt; int ui = 0;
    if (!S.next(0, cur)) return;
#ifndef NO_STAGGER
    {
        const int slot = (blockIdx.x >> 3) & 15;
        if (slot) { const unsigned long long t0 = __builtin_amdgcn_s_memrealtime(), dl = (unsigned long long)(slot * nt * 7);
            while (__builtin_amdgcn_s_memrealtime() - t0 < dl) __builtin_amdgcn_s_sleep(8); }
    }
#endif
    f32x4 acc[2][2][4][2];
#pragma unroll
    for (int a = 0; a < 2; ++a)
#pragma unroll
        for (int b = 0; b < 2; ++b)
#pragma unroll
            for (int m = 0; m < 4; ++m)
#pragma unroll
                for (int n = 0; n < 2; ++n) acc[a][b][m][n] = (f32x4){0.f, 0.f, 0.f, 0.f};
    bf16x8 At[4][2], B0[2][2], B1[2][2];
    const char* cA = (const char*)g.A + (size_t)cur.pm * tstepA; const char* cB = (const char*)g.Bt + (size_t)cur.pn * tstepB;
    PG8_STAGE(PG8_SB(0, 0), cB, voffB); PG8_STAGE(PG8_SA(0, 0), cA, voffA); PG8_STAGE(PG8_SB(0, 1), cB + hstepB, voffB); PG8_STAGE(PG8_SA(0, 1), cA + hstepA, voffA);
    if (wr == 1) PG8_BAR;
    PG8_WAIT_V(4); PG8_BAR;
    PG8_STAGE(PG8_SB(1, 0), cB + kstep, voffB); PG8_STAGE(PG8_SA(1, 0), cA + kstep, voffA); PG8_STAGE(PG8_SB(1, 1), cB + hstepB + kstep, voffB);
    PG8_WAIT_V(6); PG8_BAR;
    for (;;) {
        const bool has_next = S.next(ui + 1, nxt);
        const char* nA = has_next ? (const char*)g.A + (size_t)nxt.pm * tstepA : cA; const char* nB = has_next ? (const char*)g.Bt + (size_t)nxt.pn * tstepB : cB;
        for (int t = 0; t < nt; t += 2) {
            const bool last = (t == nt - 2);
            const char* a1 = cA + (size_t)(t + 1) * kstep;
            const char* a2 = last ? nA : cA + (size_t)(t + 2) * kstep; const char* b2 = last ? nB : cB + (size_t)(t + 2) * kstep;
            const char* a3 = a2 + kstep; const char* b3 = b2 + kstep;
            PG8_LDB(B0, 0, 0); PG8_SCHED; PG8_LDA(At, 0, 0); PG8_STAGE(PG8_SA(1, 1), a1 + hstepA, voffA);
            PG8_WAIT_L(8); PG8_BAR; PG8_WAIT_L(0); PG8_MMA(0, 0, At, B0); PG8_BAR; PG8_SCHED;
            PG8_LDB(B1, 0, 1); PG8_STAGE(PG8_SB(0, 0), b2, voffB);
            PG8_BAR; PG8_WAIT_L(0); PG8_MMA(0, 1, At, B1); PG8_BAR;
            PG8_LDA(At, 0, 1); PG8_STAGE(PG8_SA(0, 0), a2, voffA);
            PG8_BAR; PG8_WAIT_L(0); PG8_MMA(1, 0, At, B0); PG8_BAR; PG8_SCHED;
            PG8_STAGE(PG8_SB(0, 1), b2 + hstepB, voffB);
            PG8_WAIT_V(6); PG8_BAR; PG8_MMA(1, 1, At, B1); PG8_BAR;
            PG8_LDB(B0, 1, 0); PG8_SCHED; PG8_LDA(At, 1, 0); PG8_STAGE(PG8_SA(0, 1), a2 + hstepA, voffA);
            PG8_WAIT_L(8); PG8_BAR; PG8_WAIT_L(0); PG8_MMA(0, 0, At, B0); PG8_BAR; PG8_SCHED;
            PG8_LDB(B1, 1, 1); PG8_STAGE(PG8_SB(1, 0), b3, voffB);
            PG8_BAR; PG8_WAIT_L(0); PG8_MMA(0, 1, At, B1); PG8_BAR;
            PG8_LDA(At, 1, 1); PG8_STAGE(PG8_SA(1, 0), a3, voffA);
            PG8_BAR; PG8_WAIT_L(0); PG8_MMA(1, 0, At, B0); PG8_BAR; PG8_SCHED;
            PG8_STAGE(PG8_SB(1, 1), b3 + hstepB, voffB);
            PG8_WAIT_V(6); PG8_BAR; PG8_MMA(1, 1, At, B1); PG8_BAR;
        }
        E(acc, cur, wr, wc, fr, fq);
        if (!has_next) break;
#pragma unroll
        for (int a = 0; a < 2; ++a)
#pragma unroll
            for (int b = 0; b < 2; ++b)
#pragma unroll
                for (int m = 0; m < 4; ++m)
#pragma unroll
                    for (int n = 0; n < 2; ++n) acc[a][b][m][n] = (f32x4){0.f, 0.f, 0.f, 0.f};
        cur = nxt; cA = nA; cB = nB; ++ui;
    }
    PG8_WAIT_V(0);
    if (wr == 0) PG8_BAR;
    PG8_BAR;
#undef PG8_SA
#undef PG8_SB
#undef PG8_STAGE
#undef PG8_LDA
#undef PG8_LDB
#undef PG8_MMA
#undef PG8_WAIT_V
#undef PG8_WAIT_L
#undef PG8_BAR
#undef PG8_SCHED
}
}
using pg8::Unit;
typedef const f32x4 (&AccRef)[2][2][4][2];

struct Epi1 {
    static constexpr bool PERM = true;
    bf16_t *q, *kbuf, *ks, *bg, *cu, *sga, *sgb; float* out;
    DI void operator()(AccRef acc, const Unit& u, int wr, int wc, int fr, int fq) const {
        asm volatile("" : "+v"(fr), "+v"(fq));
        const int pn = u.pn, rbase = u.pm * 256 + wr * 64 + fr, cl = wc * 32 + 8 * fq;
        if (pn >= 12 && pn < 20) {
            const int ch = (pn - 12) * 128 + cl;
#pragma unroll
            for (int ai = 0; ai < 2; ++ai)
#pragma unroll
                for (int m = 0; m < 4; ++m) {
                    const int row = rbase + ai * 128 + m * 16;
                    const f32x4 p0 = acc[ai][0][m][0] * acc[ai][1][m][0], p1 = acc[ai][0][m][1] * acc[ai][1][m][1];
                    *(u32x4*)(cu + (size_t)row * D + ch) = pk8(p0, p1);
                    float* dst = nullptr;
                    if (row < MP) { const int t = row & (T - 1); if (t >= T - 2) dst = out + O_CP + ((size_t)(row >> 12) * 2 + (t - (T - 2))) * D + ch; }
                    else { const int rs = row - MP, i = rs & 31; if (i >= ST - 2) dst = out + O_CS + ((size_t)(rs >> 5) * 2 + (i - (ST - 2))) * D + ch; }
                    if (dst) { *(f32x4*)dst = p0; *(f32x4*)(dst + 4) = p1; }
                }
            return;
        }
#pragma unroll
        for (int ai = 0; ai < 2; ++ai)
#pragma unroll
            for (int m = 0; m < 4; ++m) {
                const int row = rbase + ai * 128 + m * 16;
#pragma unroll
                for (int bj = 0; bj < 2; ++bj) {
                    f32x4 v0 = acc[ai][bj][m][0], v1 = acc[ai][bj][m][1];
                    if (pn < 4) { const int col = pn * 256 + bj * 128 + cl; *(u32x4*)(q + (size_t)row * D + col) = pk8(v0 * 0.125f, v1 * 0.125f); }
                    else if (pn < 8) {
                        const int col = (pn - 4) * 256 + bj * 128 + cl;
                        bf16_t* kd; float* od;
                        const int hh = col >> 6, dd = col & 63;
                        if (row < MP) { kd = kbuf + (((size_t)(row >> 12) * NH + hh) * T + (row & (T - 1))) * HD + dd; od = out + O_KP + (size_t)row * D + col; }
                        else { const int rs = row - MP; kd = ks + (((size_t)(rs >> 5) * NH + hh) * SKV + PAST + (rs & 31)) * HD + dd; od = out + O_KS + (size_t)rs * D + col; }
                        *(u32x4*)kd = pk8(v0, v1); *(f32x4*)od = v0; *(f32x4*)(od + 4) = v1;
                    }
                    else if (pn < 12) { const int col = (pn - 8) * 256 + bj * 128 + cl; *(u32x4*)(bg + (size_t)row * D + col) = pk8(v0, v1); }
                    else {
                        bf16_t* dst = (pn < 24) ? sga : sgb; const int col = ((pn - 20) & 3) * 256 + bj * 128 + cl;
#pragma unroll
                        for (int j = 0; j < 4; ++j) { v0[j] = sigmoidf_(v0[j]); v1[j] = sigmoidf_(v1[j]); }
                        *(u32x4*)(dst + (size_t)row * D + col) = pk8(v0, v1);
                    }
                }
            }
    }
};
struct Epi1V {
    static constexpr bool PERM = true;
    bf16_t *vT, *vts; float* out;
    DI void operator()(AccRef acc, const Unit& u, int wr, int wc, int fr, int fq) const {
        asm volatile("" : "+v"(fr), "+v"(fq));
        const int rbase = u.pm * 256 + wr * 64 + fr, cl = wc * 32 + 8 * fq;
#pragma unroll
        for (int ai = 0; ai < 2; ++ai)
#pragma unroll
            for (int m = 0; m < 4; ++m) {
                const int r = rbase + ai * 128 + m * 16;
#pragma unroll
                for (int bj = 0; bj < 2; ++bj) {
                    const int tok = u.pn * 256 + bj * 128 + cl;
                    const f32x4 v0 = acc[ai][bj][m][0], v1 = acc[ai][bj][m][1];
                    float* od;
                    const int hh = r >> 6, dd = r & 63; bf16_t* vd;
                    if (tok < MP) { const int t = tok & (T - 1); vd = vT + (((size_t)(tok >> 12) * NH + hh) * (T / 32) + (t >> 5)) * 2048 + dd * 32 + ((t & 31) >> 3) * 4; od = out + O_VP + (size_t)tok * D + r; }
                    else { const int ts = tok - MP; vd = vts + (((size_t)(ts >> 5) * NH + hh) * (SKV / 32) + PAST / 32) * 2048 + dd * 32 + ((ts & 31) >> 3) * 4; od = out + O_VS + (size_t)ts * D + r; }
                    { u32x2 w0, w1; w0.x = pk2(v0[0], v0[1]); w0.y = pk2(v0[2], v0[3]); w1.x = pk2(v1[0], v1[1]); w1.y = pk2(v1[2], v1[3]); *(u32x2*)vd = w0; *(u32x2*)(vd + 16) = w1; }
#pragma unroll
                    for (int j = 0; j < 4; ++j) { od[(size_t)j * D] = v0[j]; od[(size_t)(j + 4) * D] = v1[j]; }
                }
            }
    }
};
template <int MODE  > struct EpiAB {
    static constexpr bool PERM = true;
    const bf16_t* sg; bf16_t* tm;
    DI void operator()(AccRef acc, const Unit& u, int wr, int wc, int fr, int fq) const {
        asm volatile("" : "+v"(fr), "+v"(fq));
        const int rbase = u.pm * 256 + wr * 64 + fr, cb = u.pn * 256 + wc * 32 + 8 * fq;
#pragma unroll
        for (int ai = 0; ai < 2; ++ai) {
            u32x4 sv[4][2], pv[4][2];
#pragma unroll
            for (int m = 0; m < 4; ++m)
#pragma unroll
                for (int bj = 0; bj < 2; ++bj) { const size_t o = (size_t)(rbase + ai * 128 + m * 16) * D + cb + bj * 128;
                    sv[m][bj] = *(const u32x4*)(sg + o); if (MODE == 1) pv[m][bj] = *(const u32x4*)(tm + o); }
#pragma unroll
            for (int m = 0; m < 4; ++m)
#pragma unroll
                for (int bj = 0; bj < 2; ++bj) { const size_t o = (size_t)(rbase + ai * 128 + m * 16) * D + cb + bj * 128;
                    const u32x4 s = sv[m][bj];
                    f32x4 v0 = acc[ai][bj][m][0], v1 = acc[ai][bj][m][1];
                    v0[0] *= bflo(s.x); v0[1] *= bfhi(s.x); v0[2] *= bflo(s.y); v0[3] *= bfhi(s.y);
                    v1[0] *= bflo(s.z); v1[1] *= bfhi(s.z); v1[2] *= bflo(s.w); v1[3] *= bfhi(s.w);
                    if (MODE == 1) { const u32x4 p = pv[m][bj];
                        v0[0] += bflo(p.x); v0[1] += bfhi(p.x); v0[2] += bflo(p.y); v0[3] += bfhi(p.y);
                        v1[0] += bflo(p.z); v1[1] += bfhi(p.z); v1[2] += bflo(p.w); v1[3] += bfhi(p.w); }
                    *(u32x4*)(tm + o) = pk8(v0, v1); }
        }
    }
};
template <int MODE  > struct EpiRes {
    static constexpr bool PERM = false;
    const float *xp, *xs, *mod; float* y;
    DI void operator()(AccRef acc, const Unit& u, int wr, int wc, int fr, int fq) const {
        asm volatile("" : "+v"(fr), "+v"(fq));
        const int rbase = u.pm * 256 + wr * 64 + fr, cb = u.pn * 256 + wc * 32 + 4 * fq;
        if (u.pm < MP / 256) {
            const float* gp = mod + (size_t)(u.pm >> 4) * NMOD + (MODE == 0 ? 2 * D : 5 * D) + cb;
            f32x4 gv[2][2];
#pragma unroll
            for (int bj = 0; bj < 2; ++bj)
#pragma unroll
                for (int n = 0; n < 2; ++n) gv[bj][n] = *(const f32x4*)(gp + bj * 128 + n * 16);
            const float* src = (MODE == 1) ? y : xp;
#pragma unroll
            for (int ai = 0; ai < 2; ++ai)
#pragma unroll
                for (int mp = 0; mp < 4; mp += 2) {
                    f32x4 xv[2][2][2];
#pragma unroll
                    for (int mm = 0; mm < 2; ++mm)
#pragma unroll
                        for (int bj = 0; bj < 2; ++bj)
#pragma unroll
                            for (int n = 0; n < 2; ++n) xv[mm][bj][n] = *(const f32x4*)(src + (size_t)(rbase + ai * 128 + (mp + mm) * 16) * D + cb + bj * 128 + n * 16);
#pragma unroll
                    for (int mm = 0; mm < 2; ++mm)
#pragma unroll
                        for (int bj = 0; bj < 2; ++bj)
#pragma unroll
                            for (int n = 0; n < 2; ++n) *(f32x4*)(y + (size_t)(rbase + ai * 128 + (mp + mm) * 16) * D + cb + bj * 128 + n * 16) = xv[mm][bj][n] + gv[bj][n] * acc[ai][bj][mp + mm][n];
                }
            return;
        }
#pragma unroll
        for (int ai = 0; ai < 2; ++ai)
#pragma unroll
            for (int mp = 0; mp < 4; mp += 2) {
                f32x4 xv[2][2][2], gv[2][2][2];
#pragma unroll
                for (int mm = 0; mm < 2; ++mm) { const int row = rbase + ai * 128 + (mp + mm) * 16;
                    const float* gp = mod + (size_t)bidx_of(row) * NMOD + (MODE == 0 ? 2 * D : 5 * D);
                    const float* src = (MODE == 1) ? y + (size_t)row * D : (row < MP ? xp + (size_t)row * D : xs + (size_t)(row - MP) * D);
#pragma unroll
                    for (int bj = 0; bj < 2; ++bj)
#pragma unroll
                        for (int n = 0; n < 2; ++n) { const int c = cb + bj * 128 + n * 16; xv[mm][bj][n] = *(const f32x4*)(src + c); gv[mm][bj][n] = *(const f32x4*)(gp + c); } }
#pragma unroll
                for (int mm = 0; mm < 2; ++mm) { const int row = rbase + ai * 128 + (mp + mm) * 16;
#pragma unroll
                    for (int bj = 0; bj < 2; ++bj)
#pragma unroll
                        for (int n = 0; n < 2; ++n) *(f32x4*)(y + (size_t)row * D + cb + bj * 128 + n * 16) = xv[mm][bj][n] + gv[mm][bj][n] * acc[ai][bj][mp + mm][n]; }
            }
    }
};
DI void unpack8(const u32x4 w, float (&f)[8]) { f[0] = bflo(w.x); f[1] = bfhi(w.x); f[2] = bflo(w.y); f[3] = bfhi(w.y); f[4] = bflo(w.z); f[5] = bfhi(w.z); f[6] = bflo(w.w); f[7] = bfhi(w.w); }
DI u32x4 shfl4(const u32x4 w, int src) { u32x4 r; r.x = __shfl((int)w.x, src); r.y = __shfl((int)w.y, src); r.z = __shfl((int)w.z, src); r.w = __shfl((int)w.w, src); return r; }
struct EpiUp {
    static constexpr bool PERM = true;
    bf16_t *act, *hup, *hgt, *tup, *ugs; const float *wf, *bfc; float* out;
    DI void operator()(AccRef acc, const Unit& u, int wr, int wc, int fr, int fq) const {
        asm volatile("" : "+v"(fr), "+v"(fq));
        const int ch = u.pn * 128 + wc * 32 + 8 * fq;
        if (u.pm >= MP / 256) {
#pragma unroll
            for (int ai = 0; ai < 2; ++ai)
#pragma unroll
                for (int m = 0; m < 4; ++m) { const int rs = ai * 128 + wr * 64 + m * 16 + fr, i = rs & 31;
                    *(u32x4*)(ugs + (size_t)rs * (2 * DFF) + ch) = pk8(acc[ai][0][m][0], acc[ai][0][m][1]);
                    *(u32x4*)(ugs + (size_t)rs * (2 * DFF) + DFF + ch) = pk8(acc[ai][1][m][0], acc[ai][1][m][1]);
                    if (i >= ST - 2) { float* dst = out + O_FS + ((size_t)(rs >> 5) * 2 + (i - (ST - 2))) * DFF + ch; *(f32x4*)dst = acc[ai][0][m][0]; *(f32x4*)(dst + 4) = acc[ai][0][m][1]; } }
            return;
        }
        const int src1 = fq * 16 + ((fr - 1) & 15), src2 = fq * 16 + ((fr - 2) & 15);
        u32x2 ysave[2][4];
#pragma unroll
        for (int n = 0; n < 2; ++n) {
            const int ch4 = ch + 4 * n;
            const f32x4 w0 = *(const f32x4*)(wf + ch4), w1 = *(const f32x4*)(wf + DFF + ch4), w2 = *(const f32x4*)(wf + 2 * DFF + ch4), bb = *(const f32x4*)(bfc + ch4);
#pragma unroll
            for (int ai = 0; ai < 2; ++ai) {
                const int strip = u.pm * 4 + ai * 2 + wr, row0 = u.pm * 256 + ai * 128 + wr * 64 + fr;
                u32x2 r1p = {0u, 0u}, r2p = {0u, 0u};
#pragma unroll
                for (int m = 0; m < 4; ++m) {
                    const f32x4 ua = acc[ai][0][m][n], ga = acc[ai][1][m][n];
                    u32x2 upk; upk.x = pk2(ua[0], ua[1]); upk.y = pk2(ua[2], ua[3]);
                    u32x2 r1, r2; r1.x = __shfl((int)upk.x, src1); r1.y = __shfl((int)upk.y, src1); r2.x = __shfl((int)upk.x, src2); r2.y = __shfl((int)upk.y, src2);
                    u32x2 q1, q2; q1.x = fr == 0 ? r1p.x : r1.x; q1.y = fr == 0 ? r1p.y : r1.y; q2.x = fr < 2 ? r2p.x : r2.x; q2.y = fr < 2 ? r2p.y : r2.y;
                    r1p = r1; r2p = r2;
                    const f32x4 p1 = {bflo(q1.x), bfhi(q1.x), bflo(q1.y), bfhi(q1.y)}, p2 = {bflo(q2.x), bfhi(q2.x), bflo(q2.y), bfhi(q2.y)};
                    const f32x4 uc = w0 * p2 + w1 * p1 + w2 * ua + bb;
                    f32x4 yv;
#pragma unroll
                    for (int j = 0; j < 4; ++j) yv[j] = ga[j] * uc[j] / (1.0f + __expf(-uc[j]));
                    u32x2 ypk; ypk.x = pk2(yv[0], yv[1]); ypk.y = pk2(yv[2], yv[3]);
                    const int row = row0 + m * 16;
                    if (m == 0 && fr < 2) {
                        u32x2 gpk; gpk.x = pk2(ga[0], ga[1]); gpk.y = pk2(ga[2], ga[3]);
                        *(u32x2*)(hup + ((size_t)strip * 2 + fr) * DFF + ch4) = upk;
                        *(u32x2*)(hgt + ((size_t)strip * 2 + fr) * DFF + ch4) = gpk;
                    } else if (n == 0) ysave[ai][m] = ypk;
                    else { u32x4 w; w.x = ysave[ai][m].x; w.y = ysave[ai][m].y; w.z = ypk.x; w.w = ypk.y; *(u32x4*)(act + (size_t)row * DFF + ch) = w; }
                    if (m == 3 && fr >= 14) {
                        *(u32x2*)(tup + ((size_t)strip * 2 + (fr - 14)) * DFF + ch4) = upk;
                        const int t = row & (T - 1);
                        if (t >= T - 2) *(f32x4*)(out + O_FP + ((size_t)(row >> 12) * 2 + (t - (T - 2))) * DFF + ch4) = ua;
                    }
                }
            }
        }
    }
};

DI int win_srccol(int n) {
    if (n < 2048) return n;
    if (n < 3072) return n + 1024;
    if (n < 5120) { const int j = (n - 3072) >> 8, r = (n - 3072) & 255; return r < 128 ? 4096 + 128 * j + r : 5120 + 128 * j + (r - 128); }
    return n + 1024;
}

DI int wup_srccol(int n) { const int j = n >> 8, r = n & 255; return r < 128 ? 128 * j + r : DFF + 128 * j + (r - 128); }

struct Params {
    const float *x_prompt, *x_sample, *cache_k, *cache_v, *state_conv, *state_ffn, *c_prompt, *c_sample, *w_ada, *b_ada, *g_norm1, *w_in, *w_conv, *b_conv,
                *w_branch_a, *w_branch_b, *w_out, *g_norm2, *w_up, *w_fconv, *b_fconv, *w_down, *g_final;
    float* out; unsigned char* ws;
};

DI void phase_prep(const Params& p, LAS unsigned char* lds, int tid) {
    LAS float* sm = (LAS float*)lds;
    unsigned char* ws = p.ws;
    const int G = gridDim.x, bx = blockIdx.x;
    constexpr int T_WIN = (N1 / 64) * 16, T_WV = 256, T_SQ = 256, T_WUP = (2 * DFF / 64) * 16, T_WDN = 16 * (DFF / 64), T_CV = SB * 256;
    constexpr int E1 = T_WIN, E2 = E1 + T_WV, E3 = E2 + T_SQ, E4 = E3 + T_SQ, E5 = E4 + T_SQ, E6 = E5 + T_WUP, E7 = E6 + T_WDN, E8 = E7 + T_CV;
    constexpr int S_WIN = (N1 / 64) * 4, S_WV = 64, S_SQ = 64, S_WUP = (2 * DFF / 64) * 4, S_WDN = 16 * (DFF / 256), S_CV = SB * 64;
    constexpr int F1 = S_WIN, F2 = F1 + S_WV, F3 = F2 + S_SQ, F4 = F3 + S_SQ, F5 = F4 + S_SQ, F6 = F5 + S_WUP, F7 = F6 + S_WDN, F8 = F7 + S_CV;
#define TILE_DESC(t, src, lds_, dst, ldd) do { \
        if (t < F1) { const int nt = t >> 2, kt = t & 3; src = p.w_in + (size_t)kt * 256 * 8192 + win_srccol(nt * 64); lds_ = 8192; dst = (bf16_t*)(ws + WS_WIN) + (size_t)nt * 64 * D + kt * 256; ldd = D; } \
        else if (t < F2) { const int q = t - F1, nt = q >> 2, kt = q & 3; src = p.w_in + (size_t)kt * 256 * 8192 + 2048 + nt * 64; lds_ = 8192; dst = (bf16_t*)(ws + WS_WV) + (size_t)nt * 64 * D + kt * 256; ldd = D; } \
        else if (t < F5) { const int w = (t - F2) >> 6, q = (t - F2) & 63, nt = q >> 2, kt = q & 3; \
            const float* sb = w == 0 ? p.w_branch_a : (w == 1 ? p.w_branch_b : p.w_out); const size_t off = w == 0 ? WS_WA : (w == 1 ? WS_WB : WS_WO); \
            src = sb + (size_t)kt * 256 * D + nt * 64; lds_ = D; dst = (bf16_t*)(ws + off) + (size_t)nt * 64 * D + kt * 256; ldd = D; } \
        else if (t < F6) { const int q = t - F5, nt = q >> 2, kt = q & 3; src = p.w_up + (size_t)kt * 256 * (2 * DFF) + wup_srccol(nt * 64); lds_ = 2 * DFF; dst = (bf16_t*)(ws + WS_WUP) + (size_t)nt * 64 * D + kt * 256; ldd = D; } \
        else if (t < F7) { const int q = t - F6, nt = q / (DFF / 256), kt = q % (DFF / 256); src = p.w_down + (size_t)kt * 256 * D + nt * 64; lds_ = D; dst = (bf16_t*)(ws + WS_WDN) + (size_t)nt * 64 * DFF + kt * 256; ldd = DFF; } \
        else { const int q = t - F7, b = q >> 6, nt = (q >> 2) & 15, kt = q & 3; \
            src = p.cache_v + (size_t)b * PAST * D + (size_t)kt * 256 * D + nt * 64; lds_ = D; dst = (bf16_t*)(ws + WS_VTS) + (((size_t)b * NH + nt) * (SKV / 32) + kt * 8) * 2048; ldd = -1; } } while (0)
    {
        const int c4 = tid & 15, kk0 = tid >> 4;
        for (int t = bx; t < F8; t += G) {
            const float* src; int lds_; bf16_t* dst; int ldd;
            TILE_DESC(t, src, lds_, dst, ldd);
            f32x4 rv[8];
#pragma unroll
            for (int i = 0; i < 8; ++i) rv[i] = *(const f32x4*)(src + (size_t)(kk0 + 32 * i) * lds_ + c4 * 4);
#pragma unroll
            for (int i = 0; i < 8; ++i)
#pragma unroll
                for (int j = 0; j < 4; ++j) sm[(c4 * 4 + j) * 257 + kk0 + 32 * i] = rv[i][j];
            __syncthreads();
#pragma unroll
            for (int i = 0; i < 4; ++i) { const int n = (tid >> 5) + 16 * i, k8 = (tid & 31) * 8; const LAS float* s2 = sm + n * 257 + k8;
              u32x4 w; w.x = pk2(s2[0], s2[1]); w.y = pk2(s2[2], s2[3]); w.z = pk2(s2[4], s2[5]); w.w = pk2(s2[6], s2[7]);
              if (ldd > 0) *(u32x4*)(dst + (size_t)n * ldd + k8) = w;
              else { bf16_t* vd = dst + (size_t)(k8 >> 5) * 2048 + n * 32 + ((k8 & 31) >> 3) * 4; u32x2 a; a.x = w.x; a.y = w.y; u32x2 b2; b2.x = w.z; b2.y = w.w; *(u32x2*)vd = a; *(u32x2*)(vd + 16) = b2; } }
            __syncthreads();
        }
    }
#undef TILE_DESC
    { bf16_t* ks = (bf16_t*)(ws + WS_KS);
      for (size_t i = (size_t)bx * 512 + tid; i < (size_t)SB * PAST * D / 8; i += (size_t)G * 512) {
          const size_t e = i * 8; const int b = (int)(e / ((size_t)PAST * D)); const size_t r = e % ((size_t)PAST * D);
          const f32x4 a = *(const f32x4*)(p.cache_k + e), c = *(const f32x4*)(p.cache_k + e + 4);
          const int pos = (int)(r >> 10), hh = (int)(r >> 6) & 15, dd = (int)r & 63;
          *(u32x4*)(ks + (((size_t)b * NH + hh) * SKV + pos) * HD + dd) = pk8(a, c); } }
    for (int job = bx; job < NMOD / 32; job += G) {
        __syncthreads();
        for (int i = tid; i < 24 * D; i += 512) { const int r = i >> 10, k = i & 1023; const float c = r < 16 ? p.c_prompt[r * D + k] : p.c_sample[(r - 16) * D + k]; sm[i] = c / (1.0f + __expf(-c)); }
        __syncthreads();
        const int n = tid & 31, kq = tid >> 5, col = job * 32 + n;
        float a[24];
#pragma unroll
        for (int r = 0; r < 24; ++r) a[r] = 0.f;
        for (int k = kq * 64; k < kq * 64 + 64; ++k) { const float w = p.w_ada[(size_t)k * NMOD + col];
#pragma unroll
            for (int r = 0; r < 24; ++r) a[r] += sm[r * D + k] * w; }
        __syncthreads();
#pragma unroll
        for (int r = 0; r < 24; ++r) sm[(kq * 24 + r) * 32 + n] = a[r];
        __syncthreads();
        for (int i = tid; i < 24 * 32; i += 512) { const int r = i >> 5, nn = i & 31; float s = p.b_ada[job * 32 + nn];
            for (int q = 0; q < 16; ++q) s += sm[(q * 24 + r) * 32 + nn];
            ((float*)(ws + WS_MOD))[(size_t)r * NMOD + job * 32 + nn] = s; }
    }
    __syncthreads();
}

DI void phase_norm_mod(const float* srcP, const float* srcS, const float* g, const float* mod, int shift_off, bf16_t* dst, int gw, int nw, int lane) {
    f32x4 gv[4];
#pragma unroll
    for (int i = 0; i < 4; ++i) gv[i] = *(const f32x4*)(g + lane * 4 + 256 * i);
    f32x4 cur[2][4], nxt[2][4];
#define NM_LOAD(dstv, r0) do { _Pragma("unroll") for (int rr = 0; rr < 2; ++rr) { const int row_ = (r0) + rr * nw; if (row_ < M) { \
        const float* s_ = row_ < MP ? srcP + (size_t)row_ * D : srcS + (size_t)(row_ - MP) * D; \
        _Pragma("unroll") for (int i = 0; i < 4; ++i) dstv[rr][i] = *(const f32x4*)(s_ + lane * 4 + 256 * i); } } } while (0)
    NM_LOAD(cur, gw);
    for (int row0 = gw; row0 < M; row0 += 2 * nw) {
        NM_LOAD(nxt, row0 + 2 * nw);
#pragma unroll
        for (int rr = 0; rr < 2; ++rr) { const int row = row0 + rr * nw; if (row < M) {
            float ss = 0.f;
#pragma unroll
            for (int i = 0; i < 4; ++i) ss += cur[rr][i][0] * cur[rr][i][0] + cur[rr][i][1] * cur[rr][i][1] + cur[rr][i][2] * cur[rr][i][2] + cur[rr][i][3] * cur[rr][i][3];
#pragma unroll
            for (int o = 32; o >= 1; o >>= 1) ss += __shfl_xor(ss, o);
            const float rstd = rsqrtf(ss * (1.0f / D) + 1e-6f);
            const float* mp = mod + (size_t)bidx_of(row) * NMOD + shift_off;
#pragma unroll
            for (int i = 0; i < 4; ++i) { const int c = lane * 4 + 256 * i; const f32x4 sh = *(const f32x4*)(mp + c), sc = *(const f32x4*)(mp + D + c);
                const f32x4 h = cur[rr][i] * rstd * gv[i] * (sc + 1.0f) + sh;
                u32x2 w; w.x = pk2(h[0], h[1]); w.y = pk2(h[2], h[3]); *(u32x2*)(dst + (size_t)row * D + c) = w; } } }
#pragma unroll
        for (int rr = 0; rr < 2; ++rr)
#pragma unroll
            for (int i = 0; i < 4; ++i) cur[rr][i] = nxt[rr][i];
    }
#undef NM_LOAD
}
DI void phase_final_norm(float* y, const float* g, int gw, int nw, int lane) {
    f32x4 gv[4];
#pragma unroll
    for (int i = 0; i < 4; ++i) gv[i] = *(const f32x4*)(g + lane * 4 + 256 * i);
    f32x4 cur[2][4], nxt[2][4];
#define NM_LOAD(dstv, r0) do { _Pragma("unroll") for (int rr = 0; rr < 2; ++rr) { const int row_ = (r0) + rr * nw; if (row_ < M) { \
        const float* s_ = y + (size_t)row_ * D; \
        _Pragma("unroll") for (int i = 0; i < 4; ++i) dstv[rr][i] = *(const f32x4*)(s_ + lane * 4 + 256 * i); } } } while (0)
    NM_LOAD(cur, gw);
    for (int row0 = gw; row0 < M; row0 += 2 * nw) {
        NM_LOAD(nxt, row0 + 2 * nw);
#pragma unroll
        for (int rr = 0; rr < 2; ++rr) { const int row = row0 + rr * nw; if (row < M) {
            float ss = 0.f;
#pragma unroll
            for (int i = 0; i < 4; ++i) ss += cur[rr][i][0] * cur[rr][i][0] + cur[rr][i][1] * cur[rr][i][1] + cur[rr][i][2] * cur[rr][i][2] + cur[rr][i][3] * cur[rr][i][3];
#pragma unroll
            for (int o = 32; o >= 1; o >>= 1) ss += __shfl_xor(ss, o);
            const float rstd = rsqrtf(ss * (1.0f / D) + 1e-6f);
#pragma unroll
            for (int i = 0; i < 4; ++i) *(f32x4*)(y + (size_t)row * D + lane * 4 + 256 * i) = cur[rr][i] * rstd * gv[i]; } }
#pragma unroll
        for (int rr = 0; rr < 2; ++rr)
#pragma unroll
            for (int i = 0; i < 4; ++i) cur[rr][i] = nxt[rr][i];
    }
#undef NM_LOAD
}

DI void phase_ob(const Params& p, bf16_t* bg, const bf16_t* cu, int gw, int nw, int lane) {
    for (int item = gw; item < (M / 16) * 2; item += nw) {
        const int half = item & 1, row0 = (item >> 1) * 16, ch = half * 512 + lane * 8;
        float w0[8], w1[8], w2[8], bb[8], p2[8], p1[8];
#pragma unroll
        for (int j = 0; j < 8; ++j) { w0[j] = p.w_conv[ch + j]; w1[j] = p.w_conv[D + ch + j]; w2[j] = p.w_conv[2 * D + ch + j]; bb[j] = p.b_conv[ch + j]; }
        const bool start = row0 < MP ? ((row0 & (T - 1)) == 0) : (((row0 - MP) & 31) == 0);
        if (start) {
            if (row0 < MP) {
#pragma unroll
                for (int j = 0; j < 8; ++j) { p2[j] = 0.f; p1[j] = 0.f; } }
            else { const float* sc = p.state_conv + (size_t)((row0 - MP) >> 5) * 2 * D + ch;
#pragma unroll
                for (int j = 0; j < 8; ++j) { p2[j] = sc[j]; p1[j] = sc[D + j]; } }
        } else {
            const u32x4 a = *(const u32x4*)(cu + (size_t)(row0 - 2) * D + ch), b = *(const u32x4*)(cu + (size_t)(row0 - 1) * D + ch);
            p2[0] = bflo(a.x); p2[1] = bfhi(a.x); p2[2] = bflo(a.y); p2[3] = bfhi(a.y); p2[4] = bflo(a.z); p2[5] = bfhi(a.z); p2[6] = bflo(a.w); p2[7] = bfhi(a.w);
            p1[0] = bflo(b.x); p1[1] = bfhi(b.x); p1[2] = bflo(b.y); p1[3] = bfhi(b.y); p1[4] = bflo(b.z); p1[5] = bfhi(b.z); p1[6] = bflo(b.w); p1[7] = bfhi(b.w);
        }
#pragma unroll
        for (int rb = 0; rb < 16; rb += 8) {
            u32x4 cc[8], gq[8];
#pragma unroll
            for (int r = 0; r < 8; ++r) { const size_t o = (size_t)(row0 + rb + r) * D + ch; cc[r] = *(const u32x4*)(cu + o); gq[r] = *(const u32x4*)(bg + o); }
#pragma unroll
            for (int r = 0; r < 8; ++r) {
                const u32x4 c = cc[r], q4 = gq[r];
                float cur[8] = {bflo(c.x), bfhi(c.x), bflo(c.y), bfhi(c.y), bflo(c.z), bfhi(c.z), bflo(c.w), bfhi(c.w)};
                float gg[8] = {bflo(q4.x), bfhi(q4.x), bflo(q4.y), bfhi(q4.y), bflo(q4.z), bfhi(q4.z), bflo(q4.w), bfhi(q4.w)};
                float y[8];
#pragma unroll
                for (int j = 0; j < 8; ++j) { y[j] = gg[j] * (w0[j] * p2[j] + w1[j] * p1[j] + w2[j] * cur[j] + bb[j]); p2[j] = p1[j]; p1[j] = cur[j]; }
                u32x4 w; w.x = pk2(y[0], y[1]); w.y = pk2(y[2], y[3]); w.z = pk2(y[4], y[5]); w.w = pk2(y[6], y[7]);
                *(u32x4*)(bg + (size_t)(row0 + rb + r) * D + ch) = w;
            }
        }
    }
}
DI void phase_act_fix(const Params& p, bf16_t* act, const bf16_t* hup, const bf16_t* hgt, const bf16_t* tup, const bf16_t* ugs, int gw, int nw, int lane) {
    constexpr int NSTRIP = MP / 64, NFIX = NSTRIP * 6, NSMP = (MS / 16) * 11;
    for (int item = gw; item < NFIX + NSMP; item += nw) {
        if (item < NFIX) {
            const int strip = item / 6, slab = item % 6, ch = slab * 512 + lane * 8;
            if (ch >= DFF) continue;
            float w0[8], w1[8], w2[8], bb[8], p2[8], p1[8], c0[8], c1[8], g0[8], g1[8];
#pragma unroll
            for (int j = 0; j < 8; ++j) { w0[j] = p.w_fconv[ch + j]; w1[j] = p.w_fconv[DFF + ch + j]; w2[j] = p.w_fconv[2 * DFF + ch + j]; bb[j] = p.b_fconv[ch + j]; }
            if ((strip & 63) == 0) {
#pragma unroll
                for (int j = 0; j < 8; ++j) { p2[j] = 0.f; p1[j] = 0.f; } }
            else { unpack8(*(const u32x4*)(tup + ((size_t)(strip - 1) * 2) * DFF + ch), p2); unpack8(*(const u32x4*)(tup + ((size_t)(strip - 1) * 2 + 1) * DFF + ch), p1); }
            unpack8(*(const u32x4*)(hup + ((size_t)strip * 2) * DFF + ch), c0); unpack8(*(const u32x4*)(hup + ((size_t)strip * 2 + 1) * DFF + ch), c1);
            unpack8(*(const u32x4*)(hgt + ((size_t)strip * 2) * DFF + ch), g0); unpack8(*(const u32x4*)(hgt + ((size_t)strip * 2 + 1) * DFF + ch), g1);
            float y0[8], y1[8];
#pragma unroll
            for (int j = 0; j < 8; ++j) { const float ua = w0[j] * p2[j] + w1[j] * p1[j] + w2[j] * c0[j] + bb[j], ub = w0[j] * p1[j] + w1[j] * c0[j] + w2[j] * c1[j] + bb[j];
                y0[j] = g0[j] * ua / (1.0f + __expf(-ua)); y1[j] = g1[j] * ub / (1.0f + __expf(-ub)); }
            u32x4 a, b; a.x = pk2(y0[0], y0[1]); a.y = pk2(y0[2], y0[3]); a.z = pk2(y0[4], y0[5]); a.w = pk2(y0[6], y0[7]);
            b.x = pk2(y1[0], y1[1]); b.y = pk2(y1[2], y1[3]); b.z = pk2(y1[4], y1[5]); b.w = pk2(y1[6], y1[7]);
            *(u32x4*)(act + (size_t)(strip * 64) * DFF + ch) = a; *(u32x4*)(act + (size_t)(strip * 64 + 1) * DFF + ch) = b;
        } else {
            const int q = item - NFIX, slab = q % 11, row0 = (q / 11) * 16, ch = slab * 256 + lane * 4;
            float w0[4], w1[4], w2[4], bb[4], p2[4], p1[4];
#pragma unroll
            for (int j = 0; j < 4; ++j) { w0[j] = p.w_fconv[ch + j]; w1[j] = p.w_fconv[DFF + ch + j]; w2[j] = p.w_fconv[2 * DFF + ch + j]; bb[j] = p.b_fconv[ch + j]; }
            if ((row0 & 31) == 0) { const float* sc = p.state_ffn + (size_t)(row0 >> 5) * 2 * DFF + ch;
#pragma unroll
                for (int j = 0; j < 4; ++j) { p2[j] = sc[j]; p1[j] = sc[DFF + j]; } }
            else { const u32x2 a = *(const u32x2*)(ugs + (size_t)(row0 - 2) * (2 * DFF) + ch), b = *(const u32x2*)(ugs + (size_t)(row0 - 1) * (2 * DFF) + ch);
                p2[0] = bflo(a.x); p2[1] = bfhi(a.x); p2[2] = bflo(a.y); p2[3] = bfhi(a.y); p1[0] = bflo(b.x); p1[1] = bfhi(b.x); p1[2] = bflo(b.y); p1[3] = bfhi(b.y); }
            u32x2 cc[16], gq[16];
#pragma unroll
            for (int r = 0; r < 16; ++r) { const size_t o = (size_t)(row0 + r) * (2 * DFF) + ch; cc[r] = *(const u32x2*)(ugs + o); gq[r] = *(const u32x2*)(ugs + o + DFF); }
#pragma unroll
            for (int r = 0; r < 16; ++r) {
                const u32x2 c = cc[r], q2 = gq[r];
                float cur[4] = {bflo(c.x), bfhi(c.x), bflo(c.y), bfhi(c.y)};
                float gg[4] = {bflo(q2.x), bfhi(q2.x), bflo(q2.y), bfhi(q2.y)};
                float y[4];
#pragma unroll
                for (int j = 0; j < 4; ++j) { const float uc = w0[j] * p2[j] + w1[j] * p1[j] + w2[j] * cur[j] + bb[j]; y[j] = gg[j] * uc / (1.0f + __expf(-uc)); p2[j] = p1[j]; p1[j] = cur[j]; }
                u32x2 w; w.x = pk2(y[0], y[1]); w.y = pk2(y[2], y[3]);
                *(u32x2*)(act + (size_t)(MP + row0 + r) * DFF + ch) = w;
            }
        }
    }
}


#define MFMA32(a, b, c) __builtin_amdgcn_mfma_f32_32x32x16_bf16((a), (b), (c), 0, 0, 0)
DI void sg_mma(f32x16& acc, const bf16_t* X, int ldx, const bf16_t* Y, int ldy, int K, int lane) {
    const bf16_t* xp = X + (size_t)(lane & 31) * ldx + 8 * (lane >> 5);
    const bf16_t* yp = Y + (size_t)(lane & 31) * ldy + 8 * (lane >> 5);
    for (int k0 = 0; k0 < K; k0 += 128) {
        bf16x8 xa[8], yb[8];
#pragma unroll
        for (int s2 = 0; s2 < 8; ++s2) { xa[s2] = *(const bf16x8*)(xp + k0 + 16 * s2); yb[s2] = *(const bf16x8*)(yp + k0 + 16 * s2); }
#pragma unroll
        for (int s2 = 0; s2 < 8; ++s2) acc = MFMA32(xa[s2], yb[s2], acc);
    }
}
DI f32x16 zero16() { f32x16 z;
#pragma unroll
    for (int e = 0; e < 16; ++e) z[e] = 0.f; return z; }
DI void st_bf4(bf16_t* p, float a, float b, float c, float d) { u32x2 w; w.x = pk2(a, b); w.y = pk2(c, d); *(u32x2*)p = w; }

DI void sample_p2(const bf16_t* hbuf, const bf16_t* Win, const bf16_t* Wv, bf16_t* q, bf16_t* ks, bf16_t* vts, bf16_t* bg, bf16_t* cu, bf16_t* sga, bf16_t* sgb, float* out, int gw, int lane) {
    if (gw >= 7 * 256) return;
    const int kind = gw >> 8, b = (gw >> 5) & 7, j = gw & 31, hf = lane >> 5, tl = lane & 31;
    const bf16_t* hrow = hbuf + (size_t)(MP + 32 * b) * D;
    const int row = MP + 32 * b + tl, rs = 32 * b + tl;
    if (kind == 6) {
        f32x16 acc = zero16(); sg_mma(acc, hrow, D, Wv + (size_t)(32 * j) * D, D, D, lane);
        const int dch = 32 * j + tl, hh = dch >> 6, dd = dch & 63;
#pragma unroll
        for (int g = 0; g < 4; ++g) {
            st_bf4(vts + (((size_t)b * NH + hh) * (SKV / 32) + PAST / 32) * 2048 + dd * 32 + 16 * hf + 4 * g, acc[4 * g], acc[4 * g + 1], acc[4 * g + 2], acc[4 * g + 3]);
#pragma unroll
            for (int e = 0; e < 4; ++e) out[O_VS + (size_t)(32 * b + 8 * g + 4 * hf + e) * D + dch] = acc[4 * g + e];
        }
        return;
    }
    if (kind == 3) {
        const int c0 = 32 * j, vC = 3072 + 256 * (c0 >> 7) + (c0 & 127);
        f32x16 aC = zero16(), aU = zero16();
        sg_mma(aC, Win + (size_t)vC * D, D, hrow, D, D, lane); sg_mma(aU, Win + (size_t)(vC + 128) * D, D, hrow, D, D, lane);
#pragma unroll
        for (int g = 0; g < 4; ++g) { const int c = c0 + 8 * g + 4 * hf; f32x4 pr = {aC[4 * g] * aU[4 * g], aC[4 * g + 1] * aU[4 * g + 1], aC[4 * g + 2] * aU[4 * g + 2], aC[4 * g + 3] * aU[4 * g + 3]};
            st_bf4(cu + (size_t)row * D + c, pr[0], pr[1], pr[2], pr[3]);
            if (tl >= ST - 2) *(f32x4*)(out + O_CS + ((size_t)b * 2 + (tl - (ST - 2))) * D + c) = pr; }
        return;
    }
    const int vbase = kind == 0 ? 0 : (kind == 1 ? 1024 : (kind == 2 ? 2048 : (kind == 4 ? 5120 : 6144)));
    f32x16 acc = zero16(); sg_mma(acc, Win + (size_t)(vbase + 32 * j) * D, D, hrow, D, D, lane);
#pragma unroll
    for (int g = 0; g < 4; ++g) { const int n = 32 * j + 8 * g + 4 * hf; const float a0 = acc[4 * g], a1 = acc[4 * g + 1], a2 = acc[4 * g + 2], a3 = acc[4 * g + 3];
        if (kind == 0) st_bf4(q + (size_t)row * D + n, a0 * 0.125f, a1 * 0.125f, a2 * 0.125f, a3 * 0.125f);
        else if (kind == 1) { st_bf4(ks + (((size_t)b * NH + (n >> 6)) * SKV + PAST + tl) * HD + (n & 63), a0, a1, a2, a3); *(f32x4*)(out + O_KS + (size_t)rs * D + n) = (f32x4){a0, a1, a2, a3}; }
        else if (kind == 2) st_bf4(bg + (size_t)row * D + n, a0, a1, a2, a3);
        else st_bf4((kind == 4 ? sga : sgb) + (size_t)row * D + n, sigmoidf_(a0), sigmoidf_(a1), sigmoidf_(a2), sigmoidf_(a3)); }
}
DI void sample_p4(const bf16_t* oa, const bf16_t* ob, const bf16_t* Wa, const bf16_t* Wb, const bf16_t* sga, const bf16_t* sgb, bf16_t* merged, int job, int lane) {
    const int b = job >> 5, j = job & 31, hf = lane >> 5, tl = lane & 31, row = MP + 32 * b + tl;
    f32x16 aA = zero16(), aB = zero16();
    sg_mma(aA, Wa + (size_t)(32 * j) * D, D, oa + (size_t)(MP + 32 * b) * D, D, D, lane); sg_mma(aB, Wb + (size_t)(32 * j) * D, D, ob + (size_t)(MP + 32 * b) * D, D, D, lane);
#pragma unroll
    for (int g = 0; g < 4; ++g) { const size_t o = (size_t)row * D + 32 * j + 8 * g + 4 * hf; const u32x2 sa = *(const u32x2*)(sga + o), sb = *(const u32x2*)(sgb + o);
        st_bf4(merged + o, bflo(sa.x) * aA[4 * g] + bflo(sb.x) * aB[4 * g], bfhi(sa.x) * aA[4 * g + 1] + bfhi(sb.x) * aB[4 * g + 1],
               bflo(sa.y) * aA[4 * g + 2] + bflo(sb.y) * aB[4 * g + 2], bfhi(sa.y) * aA[4 * g + 3] + bfhi(sb.y) * aB[4 * g + 3]); }
}
DI void sample_res(const bf16_t* A, int lda, const bf16_t* W, int K, const float* src, const float* gate, float* y, int job, int lane) {
    const int b = job >> 5, j = job & 31, hf = lane >> 5, tl = lane & 31;
    f32x16 acc = zero16(); sg_mma(acc, W + (size_t)(32 * j) * K, K, A + (size_t)(MP + 32 * b) * lda, lda, K, lane);
    const float* gp = gate + (size_t)(16 + b) * NMOD;
#pragma unroll
    for (int g = 0; g < 4; ++g) { const int n = 32 * j + 8 * g + 4 * hf; const f32x4 a = {acc[4 * g], acc[4 * g + 1], acc[4 * g + 2], acc[4 * g + 3]};
        *(f32x4*)(y + (size_t)(MP + 32 * b + tl) * D + n) = *(const f32x4*)(src + (size_t)(32 * b + tl) * D + n) + *(const f32x4*)(gp + n) * a; }
}
DI void sample_up(const bf16_t* h2, const bf16_t* Wup, bf16_t* ugs, float* out, int gw, int lane) {
    if (gw >= 1408) return;
    const int isg = gw >= 704 ? 1 : 0, r = gw - 704 * isg, b = r / 88, j = r % 88, hf = lane >> 5, tl = lane & 31, c0 = 32 * j;
    const int vrow = 256 * (c0 >> 7) + (c0 & 127) + 128 * isg;
    f32x16 acc = zero16(); sg_mma(acc, Wup + (size_t)vrow * D, D, h2 + (size_t)(MP + 32 * b) * D, D, D, lane);
#pragma unroll
    for (int g = 0; g < 4; ++g) { const int c = c0 + 8 * g + 4 * hf;
        st_bf4(ugs + (size_t)(32 * b + tl) * (2 * DFF) + DFF * isg + c, acc[4 * g], acc[4 * g + 1], acc[4 * g + 2], acc[4 * g + 3]);
        if (!isg && tl >= ST - 2) *(f32x4*)(out + O_FS + ((size_t)b * 2 + (tl - (ST - 2))) * DFF + c) = (f32x4){acc[4 * g], acc[4 * g + 1], acc[4 * g + 2], acc[4 * g + 3]}; }
}

DI void phase_attn(bf16_t* qo, const bf16_t* kbuf, const bf16_t* vT, const bf16_t* ks, const bf16_t* vts, LAS unsigned char* lds, int wid, int gw, int nw, int lane) {
    const int hf = lane >> 5, tl = lane & 31;
    LAS unsigned char* myl = lds + wid * (32 * 144);
    constexpr int NITEM = NB * NH * (T / 32) + SB * NH;
    for (int item = gw; item < NITEM; item += nw) {
        int qt, h, qrow0; const bf16_t *K, *VT;
        if (item < NB * NH * (T / 32)) { qt = item & 127; h = (item >> 7) & 15; const int b = item >> 11; qrow0 = b * T + qt * 32;
            K = kbuf + ((size_t)(b * NH + h) * T) * HD; VT = vT + ((size_t)(b * NH + h) * (T / 32)) * 2048; }
        else { const int s = item - NB * NH * (T / 32); h = s & 15; const int b = s >> 4; qt = PAST / 32; qrow0 = MP + b * ST;
            K = ks + ((size_t)(b * NH + h) * SKV) * HD; VT = vts + ((size_t)(b * NH + h) * (SKV / 32)) * 2048; }
        bf16x8 qf[4];
        { const bf16_t* qp = qo + (size_t)(qrow0 + tl) * D + h * HD + 8 * hf;
#pragma unroll
          for (int s = 0; s < 4; ++s) qf[s] = *(const bf16x8*)(qp + 16 * s); }
        f32x16 O0, O1;
#pragma unroll
        for (int e = 0; e < 16; ++e) { O0[e] = 0.f; O1[e] = 0.f; }
        float carry = 0.f;
        bf16x8 kf[4], vr[2][2], kfn[4], vrn[2][2];
#define AT_LOAD(kfd, vrd, kb_) do { const bf16_t* kp_ = K + (size_t)((kb_) * 32 + tl) * HD + 8 * hf; const bf16_t* vp_ = VT + (size_t)(kb_) * 2048 + tl * 32 + hf * 16; \
        _Pragma("unroll") for (int s = 0; s < 4; ++s) kfd[s] = *(const bf16x8*)(kp_ + 16 * s); \
        _Pragma("unroll") for (int dt = 0; dt < 2; ++dt) _Pragma("unroll") for (int s = 0; s < 2; ++s) vrd[dt][s] = *(const bf16x8*)(vp_ + dt * 1024 + s * 8); } while (0)
        AT_LOAD(kf, vr, qt);
        for (int kb = qt; kb >= 0; --kb) {
            if (kb > 0) AT_LOAD(kfn, vrn, kb - 1);
            f32x16 z;
#pragma unroll
            for (int e = 0; e < 16; ++e) z[e] = 0.f;
#pragma unroll
            for (int s = 0; s < 4; ++s) z = MFMA32(kf[s], qf[s], z);
            const bool diag = (kb == qt);
            float L[16];
#pragma unroll
            for (int e = 0; e < 16; ++e) { const float zz = z[e]; const float ex = __expf(-fabsf(zz)); float l = -(fmaxf(zz, 0.f) + __logf(1.0f + ex));
                if (diag) { const int key = 8 * (e >> 2) + 4 * hf + (e & 3); if (key >= tl) l = 0.f; }
                L[e] = l; }
            float Gs[4], Gp[4];
#pragma unroll
            for (int g = 0; g < 4; ++g) { Gs[g] = (L[4 * g] + L[4 * g + 1]) + (L[4 * g + 2] + L[4 * g + 3]); Gp[g] = __shfl_xor(Gs[g], 32); }
            float Tt[5]; Tt[4] = 0.f;
#pragma unroll
            for (int g = 3; g >= 0; --g) Tt[g] = Tt[g + 1] + (Gs[g] + Gp[g]);
            float a[16];
#pragma unroll
            for (int g = 0; g < 4; ++g) {
                const float s3 = Tt[g + 1] + (hf == 0 ? Gp[g] : 0.f) + carry;
                const float s2 = s3 + L[4 * g + 3], s1 = s2 + L[4 * g + 2], s0 = s1 + L[4 * g + 1];
                a[4 * g + 3] = __expf(z[4 * g + 3] + L[4 * g + 3] + s3); a[4 * g + 2] = __expf(z[4 * g + 2] + L[4 * g + 2] + s2);
                a[4 * g + 1] = __expf(z[4 * g + 1] + L[4 * g + 1] + s1); a[4 * g] = __expf(z[4 * g] + L[4 * g] + s0);
            }
            if (diag) {
#pragma unroll
                for (int e = 0; e < 16; ++e) { const int key = 8 * (e >> 2) + 4 * hf + (e & 3); if (key >= tl) a[e] = 0.f; } }
            carry += Tt[0];
#pragma unroll
            for (int s = 0; s < 2; ++s) {
                u32x4 aw; aw.x = pk2(a[8 * s], a[8 * s + 1]); aw.y = pk2(a[8 * s + 2], a[8 * s + 3]); aw.z = pk2(a[8 * s + 4], a[8 * s + 5]); aw.w = pk2(a[8 * s + 6], a[8 * s + 7]);
                const bf16x8 af = __builtin_bit_cast(bf16x8, aw);
                O0 = MFMA32(vr[0][s], af, O0); O1 = MFMA32(vr[1][s], af, O1);
            }
#ifndef NO_EARLY_EXIT
            if (__all(carry < -104.5f)) break;
#endif
#pragma unroll
            for (int s = 0; s < 4; ++s) kf[s] = kfn[s];
#pragma unroll
            for (int dt = 0; dt < 2; ++dt)
#pragma unroll
                for (int s = 0; s < 2; ++s) vr[dt][s] = vrn[dt][s];
        }
#undef AT_LOAD
#pragma unroll
        for (int g = 0; g < 4; ++g) {
            u32x2 w0; w0.x = pk2(O0[4 * g], O0[4 * g + 1]); w0.y = pk2(O0[4 * g + 2], O0[4 * g + 3]);
            u32x2 w1; w1.x = pk2(O1[4 * g], O1[4 * g + 1]); w1.y = pk2(O1[4 * g + 2], O1[4 * g + 3]);
            *(LAS u32x2*)(myl + tl * 144 + (8 * g + 4 * hf) * 2) = w0;
            *(LAS u32x2*)(myl + tl * 144 + (32 + 8 * g + 4 * hf) * 2) = w1;
        }
        asm volatile("s_waitcnt lgkmcnt(0)" ::: "memory");
#pragma unroll
        for (int it = 0; it < 4; ++it) { const int chunk = it * 64 + lane, row = chunk >> 3, c16 = chunk & 7;
            const u32x4 w = *(const LAS u32x4*)(myl + row * 144 + c16 * 16);
            *(u32x4*)(qo + (size_t)(qrow0 + row) * D + h * HD + c16 * 8) = w; }
        asm volatile("s_waitcnt lgkmcnt(0)" ::: "memory");
    }
}

__global__ void __launch_bounds__(512, 2) fwd_megakernel(Params p) {
    extern __shared__ __attribute__((aligned(16))) unsigned char smem[];
    LAS unsigned char* lds = (LAS unsigned char*)smem;
    cg::grid_group grid = cg::this_grid();
    const int G = gridDim.x, bx = blockIdx.x, nw = G * 8;
#define LANE_ARGS(t_) (bx * 8 + __builtin_amdgcn_readfirstlane((t_) >> 6)), nw, ((t_) & 63)
    unsigned char* ws = p.ws;
    bf16_t* Win = (bf16_t*)(ws + WS_WIN); bf16_t* Wv = (bf16_t*)(ws + WS_WV); bf16_t* Wa = (bf16_t*)(ws + WS_WA); bf16_t* Wb = (bf16_t*)(ws + WS_WB);
    bf16_t* Wo = (bf16_t*)(ws + WS_WO); bf16_t* Wup = (bf16_t*)(ws + WS_WUP); bf16_t* Wdn = (bf16_t*)(ws + WS_WDN);
    float* mod = (float*)(ws + WS_MOD); bf16_t* ks = (bf16_t*)(ws + WS_KS); bf16_t* vts = (bf16_t*)(ws + WS_VTS);
    bf16_t* slot0 = (bf16_t*)(ws + WS_SLOT0);
    bf16_t* hbuf = (bf16_t*)(ws + WS_BIG);
    bf16_t* kbuf = (bf16_t*)(ws + WS_BIG + U); bf16_t* vT = (bf16_t*)(ws + WS_BIG + 2 * U);
    bf16_t* bg = (bf16_t*)(ws + WS_BIG + 3 * U); bf16_t* cu = (bf16_t*)(ws + WS_BIG + 4 * U);
    bf16_t* act = (bf16_t*)(ws + WS_ACT); bf16_t* hup = (bf16_t*)(ws + WS_HUP); bf16_t* hgt = (bf16_t*)(ws + WS_HGT); bf16_t* tup = (bf16_t*)(ws + WS_TUP); bf16_t* ugs = (bf16_t*)(ws + WS_UGS);
    bf16_t* sga = (bf16_t*)p.out; bf16_t* sgb = (bf16_t*)((unsigned char*)p.out + U);
    float* y = p.out + O_Y;

    phase_prep(p, lds, tid_());
    grid.sync();
    { const int t_ = tid_(); phase_norm_mod(p.x_prompt, p.x_sample, p.g_norm1, mod, 0, hbuf, LANE_ARGS(t_)); }
    grid.sync();
    { const int t_ = tid_(); sample_p2(hbuf, Win, Wv, slot0, ks, vts, bg, cu, sga, sgb, p.out, bx * 8 + __builtin_amdgcn_readfirstlane(t_ >> 6), t_ & 63); }
    { pg8::Gemm g{hbuf, Win, MP, N1, D, D, D}; pg8::StaticOrder S; S.init(MP, N1, G, bx);
      Epi1 E{slot0, kbuf, ks, bg, cu, sga, sgb, p.out}; pg8::gemm_phase<Epi1>(lds, g, S, E); }
    { pg8::Gemm g{Wv, hbuf, D, MP, D, D, D}; pg8::StaticOrder S; S.init(D, MP, G, bx);
      Epi1V E{vT, vts, p.out}; pg8::gemm_phase<Epi1V>(lds, g, S, E); }
    grid.sync();
    { const int t_ = tid_(); phase_attn(slot0, kbuf, vT, ks, vts, lds, __builtin_amdgcn_readfirstlane(t_ >> 6), LANE_ARGS(t_)); }
    { const int t_ = tid_(); phase_ob(p, bg, cu, LANE_ARGS(t_)); }
    grid.sync();
    { const int t_ = tid_(); if (t_ < 64) sample_p4(slot0, bg, Wa, Wb, sga, sgb, hbuf, bx, t_); }
    { pg8::Gemm g{slot0, Wa, MP, D, D, D, D}; pg8::StaticOrder S; S.init(MP, D, G, bx); EpiAB<0> E{sga, hbuf}; pg8::gemm_phase<EpiAB<0>>(lds, g, S, E); }
    { pg8::Gemm g{bg, Wb, MP, D, D, D, D}; pg8::StaticOrder S; S.init(MP, D, G, bx); EpiAB<1> E{sgb, hbuf}; pg8::gemm_phase<EpiAB<1>>(lds, g, S, E); }
    grid.sync();
    { const int t_ = tid_(); if (t_ < 64) sample_res(hbuf, D, Wo, D, p.x_sample, mod + 2 * D, y, bx, t_); }
    { pg8::Gemm g{hbuf, Wo, MP, D, D, D, D}; pg8::StaticOrder S; S.init(MP, D, G, bx); EpiRes<0> E{p.x_prompt, p.x_sample, mod, y}; pg8::gemm_phase<EpiRes<0>>(lds, g, S, E); }
    grid.sync();
    { const int t_ = tid_(); phase_norm_mod(y, y + (size_t)MP * D, p.g_norm2, mod, 3 * D, slot0, LANE_ARGS(t_)); }
    grid.sync();
    { const int t_ = tid_(); sample_up(slot0, Wup, ugs, p.out, bx * 8 + __builtin_amdgcn_readfirstlane(t_ >> 6), t_ & 63); }
    { pg8::Gemm g{slot0, Wup, MP, 2 * DFF, D, D, D}; pg8::StaticOrder S; S.init(MP, 2 * DFF, G, bx); EpiUp E{act, hup, hgt, tup, ugs, p.w_fconv, p.b_fconv, p.out}; pg8::gemm_phase<EpiUp>(lds, g, S, E); }
    grid.sync();
    { const int t_ = tid_(); phase_act_fix(p, act, hup, hgt, tup, ugs, LANE_ARGS(t_)); }
    grid.sync();
    { const int t_ = tid_(); if (t_ < 64) sample_res(act, DFF, Wdn, DFF, y + (size_t)MP * D, mod + 5 * D, y, bx, t_); }
    { pg8::Gemm g{act, Wdn, MP, D, DFF, DFF, DFF}; pg8::StaticOrder S; S.init(MP, D, G, bx); EpiRes<1> E{nullptr, nullptr, mod, y}; pg8::gemm_phase<EpiRes<1>>(lds, g, S, E); }
    grid.sync();
    { const int t_ = tid_(); phase_final_norm(y, p.g_final, LANE_ARGS(t_)); }
}

extern "C" void kernel_launch(void* const* d_in, const int* in_sizes, int n_in, void* d_out, int out_size, void* d_ws, size_t ws_size, hipStream_t stream) {
    static int grid_blocks = 0;
    if (grid_blocks == 0) {
        if (n_in != 23 || (size_t)out_size != O_END || ws_size < WS_END) { fprintf(stderr, "kernel_launch: unexpected shapes: n_in %d out %d ws %zu (need %zu)\n", n_in, out_size, ws_size, (size_t)WS_END); grid_blocks = -1; return; }
        int dev = 0, cus = 0, per_cu = 0;
        hipGetDevice(&dev);
        hipDeviceGetAttribute(&cus, hipDeviceAttributeMultiprocessorCount, dev);
        if (hipFuncSetAttribute((const void*)fwd_megakernel, hipFuncAttributeMaxDynamicSharedMemorySize, LDS_BYTES) != hipSuccess) { fprintf(stderr, "kernel_launch: hipFuncSetAttribute failed\n"); grid_blocks = -1; return; }
        hipOccupancyMaxActiveBlocksPerMultiprocessor(&per_cu, (const void*)fwd_megakernel, 512, LDS_BYTES);
        if (per_cu < 1) { fprintf(stderr, "kernel_launch: occupancy query says 0 blocks per CU\n"); per_cu = 1; }
        grid_blocks = cus * 1;
        (void)hipGetLastError();
    }
    if (grid_blocks < 0) return;
    Params p{};
    const float** pp = (const float**)&p;
    for (int i = 0; i < 23; ++i) pp[i] = (const float*)d_in[i];
    p.out = (float*)d_out; p.ws = (unsigned char*)d_ws;
    void* args[] = {&p};
    hipError_t e = hipLaunchCooperativeKernel((const void*)fwd_megakernel, dim3(grid_blocks), dim3(512), args, LDS_BYTES, stream);
    if (e != hipSuccess) fprintf(stderr, "cooperative launch failed: %s (grid %d)\n", hipGetErrorString(e), grid_blocks);
}
```

```cpp
#include <hip/hip_runtime.h>
#include <hip/hip_cooperative_groups.h>
#include <cstdio>
namespace cg = cooperative_groups;

#define LAS __attribute__((address_space(3)))
#define DI __device__ __forceinline__
typedef unsigned short bf16_t;
typedef short bf16x8 __attribute__((ext_vector_type(8)));
typedef short s16x4 __attribute__((ext_vector_type(4)));
typedef float f32x2 __attribute__((ext_vector_type(2)));
typedef float f32x4 __attribute__((ext_vector_type(4)));
typedef float f32x16 __attribute__((ext_vector_type(16)));
typedef unsigned u32x2 __attribute__((ext_vector_type(2)));
typedef unsigned u32x4 __attribute__((ext_vector_type(4)));
typedef __bf16 bf2_t __attribute__((ext_vector_type(2)));

constexpr int D = 1024, NB = 16, T = 4096, MP = NB * T, SB = 8, ST = 32, MS = SB * ST, M = MP + MS;
constexpr int PAST = 1024, SKV = PAST + ST, DFF = 2816, NH = 16, HD = 64, NMOD = 6 * D;
constexpr int N1 = 7168;
constexpr size_t O_Y = 0, O_KP = 67371008, O_VP = 134479872, O_CP = 201588736, O_FP = 201621504, O_KS = 201711616,
                 O_VS = 201973760, O_CS = 202235904, O_FS = 202252288, O_END = 202297344;
constexpr size_t U = (size_t)M * D * 2;
constexpr size_t WS_WIN = 0, WS_WV = WS_WIN + (size_t)N1 * D * 2, WS_WA = WS_WV + (size_t)D * D * 2, WS_WB = WS_WA + (size_t)D * D * 2,
                 WS_WO = WS_WB + (size_t)D * D * 2, WS_WUP = WS_WO + (size_t)D * D * 2, WS_WDN = WS_WUP + (size_t)2 * DFF * D * 2,
                 WS_MOD = WS_WDN + (size_t)D * DFF * 2, WS_KS = WS_MOD + (size_t)24 * NMOD * 4, WS_VTS = WS_KS + (size_t)SB * SKV * D * 2,
                 WS_SLOT0 = WS_VTS + (size_t)SB * D * SKV * 2, WS_BIG = WS_SLOT0 + U,
                 WS_ACT = WS_BIG,
                 WS_HUP = WS_ACT + (size_t)M * DFF * 2, WS_HGT = WS_HUP + (size_t)(MP / 64) * 2 * DFF * 2, WS_TUP = WS_HGT + (size_t)(MP / 64) * 2 * DFF * 2,
                 WS_UGS = WS_TUP + (size_t)(MP / 64) * 2 * DFF * 2, WS_ACT_END = WS_UGS + (size_t)MS * 2 * DFF * 2,
                 WS_END = (WS_BIG + 5 * U > WS_ACT_END) ? WS_BIG + 5 * U : WS_ACT_END;
constexpr int LDS_BYTES = 131072 + 64;
constexpr size_t WS_BAR = WS_END + 4096;
constexpr float QSCALE = 0.125f * 1.4426950408889634f;
#ifndef STAG_P4
#define STAG_P4 0
#define STAG_P5 0
#define STAG_P9 0
#endif

DI unsigned pk2(float lo, float hi) { f32x2 v = {lo, hi}; return __builtin_bit_cast(unsigned, __builtin_convertvector(v, bf2_t)); }
DI float bflo(unsigned w) { return __uint_as_float(w << 16); }
DI float bfhi(unsigned w) { return __uint_as_float(w & 0xffff0000u); }
DI u32x4 pk8(f32x4 a, f32x4 b) { u32x4 w; w.x = pk2(a[0], a[1]); w.y = pk2(a[2], a[3]); w.z = pk2(b[0], b[1]); w.w = pk2(b[2], b[3]); return w; }
DI float sigmoidf_(float x) { return __builtin_amdgcn_rcpf(1.0f + __expf(-x)); }
DI int tid_() { int t = threadIdx.x; asm volatile("" : "+v"(t)); return t; }
DI int bidx_of(int row) { return row < MP ? (row >> 12) : 16 + ((row - MP) >> 5); }

namespace pg8 {
constexpr int BM = 256, BK = 64, HALF = 128, HTB = HALF * BK * 2, STAGE_BYTES = 8 * HTB, NXCD = 8, WGM = 8;
DI int lds_byte(int r, int c) { const int st = (r >> 4) * 2 + (c >> 5), rr = r & 15, cc = c & 31, ob = rr * 64 + cc * 2; return st * 1024 + (ob ^ (((ob >> 9) & 1) << 5)); }
DI void stage_rc(int b, int& R, int& C) { const int st = b / 1024, sb = b % 1024, swz = sb ^ (((sb >> 9) & 1) << 5); R = (st >> 1) * 16 + swz / 64; C = (st & 1) * 32 + (swz % 64) / 2; }
DI int perm32(int rho) { const int n = rho >> 4, i = rho & 15; return 8 * (i >> 2) + 4 * n + (i & 3); }
struct Unit { int pm, pn; };
struct Gemm { const bf16_t* A; const bf16_t* Bt; int M, N, K, lda, ldb; };
struct StaticOrder {
    int nM, nN, nwg, G, c;
    DI void init(int M_, int N_, int G_, int c_) { nM = M_ / BM; nN = N_ / BM; nwg = nM * nN; G = G_; c = c_; }
    DI bool next(int i, Unit& u) const {
        const long L = (long)i * G + c; if (L >= nwg) return false;
        int wgid = (int)L; { const int q = nwg / NXCD, r = nwg % NXCD, xcd = wgid % NXCD, off = wgid / NXCD; wgid = (xcd < r ? xcd * (q + 1) : r * (q + 1) + (xcd - r) * q) + off; }
        const int nig = WGM * nN, gid = wgid / nig, fm = gid * WGM, gsz = (nM - fm) < WGM ? (nM - fm) : WGM;
        u.pm = fm + ((wgid % nig) % gsz); u.pn = (wgid % nig) / gsz; return true;
    }
};

template <class Epi>
DI void gemm_phase(LAS unsigned char* lds, const Gemm g, const StaticOrder& S, const Epi& E, int stag = 0) {
    const int tid = tid_(), wid = __builtin_amdgcn_readfirstlane(tid >> 6), lane = tid & 63, wr = wid >> 2, wc = wid & 3, fr = lane & 15, fq = lane >> 4;
    const int K = g.K, nt = K / BK;
    unsigned voffA[2], voffB[2];
#pragma unroll
    for (int i = 0; i < 2; ++i) { int R, C; stage_rc(tid * 16 + i * 8192, R, C); const int Rb = Epi::PERM ? ((R & ~31) + perm32(R & 31)) : R;
        voffA[i] = (unsigned)(R * g.lda + C) * 2u; voffB[i] = (unsigned)(Rb * g.ldb + C) * 2u; }
    const size_t kstep = (size_t)(BK * 2);
    const size_t hstepA = (size_t)HALF * g.lda * 2, hstepB = (size_t)HALF * g.ldb * 2;
    const size_t tstepA = 2 * hstepA, tstepB = 2 * hstepB;
    const unsigned ldsw = (unsigned)wid * 1024u;
    const int aoff = lds_byte(wr * 64 + fr, fq * 8), boff = lds_byte(wc * 32 + fr, fq * 8);
#define PG8_SA(b, h) (((b) * 2 + (h)) * HTB)
#define PG8_SB(b, h) ((4 + (b) * 2 + (h)) * HTB)
#define PG8_STAGE(bufoff, gbase, voff) do { _Pragma("unroll") for (int _i = 0; _i < 2; ++_i) \
        __builtin_amdgcn_global_load_lds((const unsigned*)((const char*)(gbase) + (voff)[_i]), (LAS unsigned*)(lds + (bufoff) + ldsw + _i * 8192), 16, 0, 0); } while (0)
#define PG8_LDA(dst, b, h) do { _Pragma("unroll") for (int m = 0; m < 4; ++m) _Pragma("unroll") for (int k = 0; k < 2; ++k) dst[m][k] = *(const LAS bf16x8*)(lds + PG8_SA(b, h) + aoff + m * 2048 + k * 1024); } while (0)
#define PG8_LDB(dst, b, h) do { _Pragma("unroll") for (int n = 0; n < 2; ++n) _Pragma("unroll") for (int k = 0; k < 2; ++k) dst[n][k] = *(const LAS bf16x8*)(lds + PG8_SB(b, h) + boff + n * 2048 + k * 1024); } while (0)
#define PG8_MMA(ai, bj, At, Bt) do { __builtin_amdgcn_s_setprio(1); _Pragma("unroll") for (int m = 0; m < 4; ++m) _Pragma("unroll") for (int n = 0; n < 2; ++n) _Pragma("unroll") for (int k = 0; k < 2; ++k) \
        acc[ai][bj][m][n] = __builtin_amdgcn_mfma_f32_16x16x32_bf16(Bt[n][k], At[m][k], acc[ai][bj][m][n], 0, 0, 0); __builtin_amdgcn_s_setprio(0); } while (0)
#define PG8_WAIT_V(n) asm volatile("s_waitcnt vmcnt(" #n ")" ::: "memory")
#define PG8_WAIT_L(n) asm volatile("s_waitcnt lgkmcnt(" #n ")" ::: "memory")
#define PG8_BAR __builtin_amdgcn_s_barrier()
#define PG8_SCHED __builtin_amdgcn_sched_barrier(0)
    Unit cur, nxt; int ui = 0;
    if (!S.next(0, cur)) return;
    if (stag) {
        const int slot = (blockIdx.x >> 3) & 15;
        if (slot) { const unsigned long long t0 = __builtin_amdgcn_s_memrealtime(), dl = (unsigned long long)(slot * stag) >> 4;
            while (__builtin_amdgcn_s_memrealtime() - t0 < dl) __builtin_amdgcn_s_sleep(8); }
    }
    f32x4 acc[2][2][4][2];
#pragma unroll
    for (int a = 0; a < 2; ++a)
#pragma unroll
        for (int b = 0; b < 2; ++b)
#pragma unroll
            for (int m = 0; m < 4; ++m)
#pragma unroll
                for (int n = 0; n < 2; ++n) acc[a][b][m][n] = (f32x4){0.f, 0.f, 0.f, 0.f};
    bf16x8 At[4][2], B0[2][2], B1[2][2];
    const char* cA = (const char*)g.A + (size_t)cur.pm * tstepA; const char* cB = (const char*)g.Bt + (size_t)cur.pn * tstepB;
    PG8_STAGE(PG8_SB(0, 0), cB, voffB); PG8_STAGE(PG8_SA(0, 0), cA, voffA); PG8_STAGE(PG8_SB(0, 1), cB + hstepB, voffB); PG8_STAGE(PG8_SA(0, 1), cA + hstepA, voffA);
    if (wr == 1) PG8_BAR;
    PG8_WAIT_V(4); PG8_BAR;
    PG8_STAGE(PG8_SB(1, 0), cB + kstep, voffB); PG8_STAGE(PG8_SA(1, 0), cA + kstep, voffA); PG8_STAGE(PG8_SB(1, 1), cB + hstepB + kstep, voffB);
    PG8_WAIT_V(6); PG8_BAR;
    for (;;) {
        const bool has_next = S.next(ui + 1, nxt);
        const char* nA = has_next ? (const char*)g.A + (size_t)nxt.pm * tstepA : cA; const char* nB = has_next ? (const char*)g.Bt + (size_t)nxt.pn * tstepB : cB;
        for (int t = 0; t < nt; t += 2) {
            const bool last = (t == nt - 2);
            const char* a1 = cA + (size_t)(t + 1) * kstep;
            const char* a2 = last ? nA : cA + (size_t)(t + 2) * kstep; const char* b2 = last ? nB : cB + (size_t)(t + 2) * kstep;
            const char* a3 = a2 + kstep; const char* b3 = b2 + kstep;
            PG8_LDB(B0, 0, 0); PG8_SCHED; PG8_LDA(At, 0, 0); PG8_STAGE(PG8_SA(1, 1), a1 + hstepA, voffA);
            PG8_WAIT_L(8); PG8_BAR; PG8_WAIT_L(0); PG8_MMA(0, 0, At, B0); PG8_BAR; PG8_SCHED;
            PG8_LDB(B1, 0, 1); PG8_STAGE(PG8_SB(0, 0), b2, voffB);
            PG8_BAR; PG8_WAIT_L(0); PG8_MMA(0, 1, At, B1); PG8_BAR;
            PG8_LDA(At, 0, 1); PG8_STAGE(PG8_SA(0, 0), a2, voffA);
            PG8_BAR; PG8_WAIT_L(0); PG8_MMA(1, 0, At, B0); PG8_BAR; PG8_SCHED;
            PG8_STAGE(PG8_SB(0, 1), b2 + hstepB, voffB);
            PG8_WAIT_V(6); PG8_BAR; PG8_MMA(1, 1, At, B1); PG8_BAR;
            PG8_LDB(B0, 1, 0); PG8_SCHED; PG8_LDA(At, 1, 0); PG8_STAGE(PG8_SA(0, 1), a2 + hstepA, voffA);
            PG8_WAIT_L(8); PG8_BAR; PG8_WAIT_L(0); PG8_MMA(0, 0, At, B0); PG8_BAR; PG8_SCHED;
            PG8_LDB(B1, 1, 1); PG8_STAGE(PG8_SB(1, 0), b3, voffB);
            PG8_BAR; PG8_WAIT_L(0); PG8_MMA(0, 1, At, B1); PG8_BAR;
            PG8_LDA(At, 1, 1); PG8_STAGE(PG8_SA(1, 0), a3, voffA);
            PG8_BAR; PG8_WAIT_L(0); PG8_MMA(1, 0, At, B0); PG8_BAR; PG8_SCHED;
            PG8_STAGE(PG8_SB(1, 1), b3 + hstepB, voffB);
            PG8_WAIT_V(6); PG8_BAR; PG8_MMA(1, 1, At, B1); PG8_BAR;
        }
        E(acc, cur, wr, wc, fr, fq);
        if (!has_next) break;
#pragma unroll
        for (int a = 0; a < 2; ++a)
#pragma unroll
            for (int b = 0; b < 2; ++b)
#pragma unroll
                for (int m = 0; m < 4; ++m)
#pragma unroll
                    for (int n = 0; n < 2; ++n) acc[a][b][m][n] = (f32x4){0.f, 0.f, 0.f, 0.f};
        cur = nxt; cA = nA; cB = nB; ++ui;
    }
    PG8_WAIT_V(0);
    if (wr == 0) PG8_BAR;
    PG8_BAR;
#undef PG8_SA
#undef PG8_SB
#undef PG8_STAGE
#undef PG8_LDA
#undef PG8_LDB
#undef PG8_MMA
#undef PG8_WAIT_V
#undef PG8_WAIT_L
#undef PG8_BAR
#undef PG8_SCHED
}
}
using pg8::Unit;
typedef const f32x4 (&AccRef)[2][2][4][2];

struct Epi1 {
    static constexpr bool PERM = true;
    bf16_t *q, *kbuf, *ks, *bg, *cu, *sga, *sgb; float* out;
    DI void operator()(AccRef acc, const Unit& u, int wr, int wc, int fr, int fq) const {
        asm volatile("" : "+v"(fr), "+v"(fq));
        const int pn = u.pn, rbase = u.pm * 256 + wr * 64 + fr, cl = wc * 32 + 8 * fq;
        if (pn >= 12 && pn < 20) {
            const int ch = (pn - 12) * 128 + cl;
#pragma unroll
            for (int ai = 0; ai < 2; ++ai)
#pragma unroll
                for (int m = 0; m < 4; ++m) {
                    const int row = rbase + ai * 128 + m * 16;
                    const f32x4 p0 = acc[ai][0][m][0] * acc[ai][1][m][0], p1 = acc[ai][0][m][1] * acc[ai][1][m][1];
                    *(u32x4*)(cu + (size_t)row * D + ch) = pk8(p0, p1);
                    float* dst = nullptr;
                    if (row < MP) { const int t = row & (T - 1); if (t >= T - 2) dst = out + O_CP + ((size_t)(row >> 12) * 2 + (t - (T - 2))) * D + ch; }
                    else { const int rs = row - MP, i = rs & 31; if (i >= ST - 2) dst = out + O_CS + ((size_t)(rs >> 5) * 2 + (i - (ST - 2))) * D + ch; }
                    if (dst) { *(f32x4*)dst = p0; *(f32x4*)(dst + 4) = p1; }
                }
            return;
        }
#pragma unroll
        for (int ai = 0; ai < 2; ++ai)
#pragma unroll
            for (int m = 0; m < 4; ++m) {
                const int row = rbase + ai * 128 + m * 16;
#pragma unroll
                for (int bj = 0; bj < 2; ++bj) {
                    f32x4 v0 = acc[ai][bj][m][0], v1 = acc[ai][bj][m][1];
                    if (pn < 4) { const int col = pn * 256 + bj * 128 + cl; *(u32x4*)(q + (size_t)row * D + col) = pk8(v0 * QSCALE, v1 * QSCALE); }
                    else if (pn < 8) {
                        const int col = (pn - 4) * 256 + bj * 128 + cl;
                        bf16_t* kd; float* od;
                        const int hh = col >> 6, dd = col & 63;
                        if (row < MP) { kd = kbuf + (((size_t)(row >> 12) * NH + hh) * T + (row & (T - 1))) * HD + dd; od = out + O_KP + (size_t)row * D + col; }
                        else { const int rs = row - MP; kd = ks + (((size_t)(rs >> 5) * NH + hh) * SKV + PAST + (rs & 31)) * HD + dd; od = out + O_KS + (size_t)rs * D + col; }
                        *(u32x4*)kd = pk8(v0, v1); *(f32x4*)od = v0; *(f32x4*)(od + 4) = v1;
                    }
                    else if (pn < 12) { const int col = (pn - 8) * 256 + bj * 128 + cl; *(u32x4*)(bg + (size_t)row * D + col) = pk8(v0, v1); }
                    else {
                        bf16_t* dst = (pn < 24) ? sga : sgb; const int col = ((pn - 20) & 3) * 256 + bj * 128 + cl;
#pragma unroll
                        for (int j = 0; j < 4; ++j) { v0[j] = sigmoidf_(v0[j]); v1[j] = sigmoidf_(v1[j]); }
                        *(u32x4*)(dst + (size_t)row * D + col) = pk8(v0, v1);
                    }
                }
            }
    }
};
struct Epi1V {
    static constexpr bool PERM = true;
    bf16_t *vT, *vts; float* out;
    DI void operator()(AccRef acc, const Unit& u, int wr, int wc, int fr, int fq) const {
        asm volatile("" : "+v"(fr), "+v"(fq));
        const int rbase = u.pm * 256 + wr * 64 + fr, cl = wc * 32 + 8 * fq;
#pragma unroll
        for (int ai = 0; ai < 2; ++ai)
#pragma unroll
            for (int m = 0; m < 4; ++m) {
                const int r = rbase + ai * 128 + m * 16;
#pragma unroll
                for (int bj = 0; bj < 2; ++bj) {
                    const int tok = u.pn * 256 + bj * 128 + cl;
                    const f32x4 v0 = acc[ai][bj][m][0], v1 = acc[ai][bj][m][1];
                    float* od;
                    const int hh = r >> 6, dd = r & 63; bf16_t* vd;
                    if (tok < MP) { const int t = tok & (T - 1); vd = vT + (((size_t)(tok >> 12) * NH + hh) * (T / 32) + (t >> 5)) * 2048 + dd * 32 + ((t & 31) >> 3) * 4; od = out + O_VP + (size_t)tok * D + r; }
                    else { const int ts = tok - MP; vd = vts + (((size_t)(ts >> 5) * NH + hh) * (SKV / 32) + PAST / 32) * 2048 + dd * 32 + ((ts & 31) >> 3) * 4; od = out + O_VS + (size_t)ts * D + r; }
                    { u32x2 w0, w1; w0.x = pk2(v0[0], v0[1]); w0.y = pk2(v0[2], v0[3]); w1.x = pk2(v1[0], v1[1]); w1.y = pk2(v1[2], v1[3]); *(u32x2*)vd = w0; *(u32x2*)(vd + 16) = w1; }
#pragma unroll
                    for (int j = 0; j < 4; ++j) { od[(size_t)j * D] = v0[j]; od[(size_t)(j + 4) * D] = v1[j]; }
                }
            }
    }
};
template <int MODE  > struct EpiAB {
    static constexpr bool PERM = true;
    const bf16_t* sg; bf16_t* tm;
    DI void operator()(AccRef acc, const Unit& u, int wr, int wc, int fr, int fq) const {
        asm volatile("" : "+v"(fr), "+v"(fq));
        const int rbase = u.pm * 256 + wr * 64 + fr, cb = u.pn * 256 + wc * 32 + 8 * fq;
#pragma unroll
        for (int ai = 0; ai < 2; ++ai) {
            u32x4 sv[4][2], pv[4][2];
#pragma unroll
            for (int m = 0; m < 4; ++m)
#pragma unroll
                for (int bj = 0; bj < 2; ++bj) { const size_t o = (size_t)(rbase + ai * 128 + m * 16) * D + cb + bj * 128;
                    sv[m][bj] = *(const u32x4*)(sg + o); if (MODE == 1) pv[m][bj] = *(const u32x4*)(tm + o); }
#pragma unroll
            for (int m = 0; m < 4; ++m)
#pragma unroll
                for (int bj = 0; bj < 2; ++bj) { const size_t o = (size_t)(rbase + ai * 128 + m * 16) * D + cb + bj * 128;
                    const u32x4 s = sv[m][bj];
                    f32x4 v0 = acc[ai][bj][m][0], v1 = acc[ai][bj][m][1];
                    v0[0] *= bflo(s.x); v0[1] *= bfhi(s.x); v0[2] *= bflo(s.y); v0[3] *= bfhi(s.y);
                    v1[0] *= bflo(s.z); v1[1] *= bfhi(s.z); v1[2] *= bflo(s.w); v1[3] *= bfhi(s.w);
                    if (MODE == 1) { const u32x4 p = pv[m][bj];
                        v0[0] += bflo(p.x); v0[1] += bfhi(p.x); v0[2] += bflo(p.y); v0[3] += bfhi(p.y);
                        v1[0] += bflo(p.z); v1[1] += bfhi(p.z); v1[2] += bflo(p.w); v1[3] += bfhi(p.w); }
                    *(u32x4*)(tm + o) = pk8(v0, v1); }
        }
    }
};
template <int MODE  > struct EpiRes {
    static constexpr bool PERM = true;
    const float *xp, *mod; bf16_t* xb;
    DI void operator()(AccRef acc, const Unit& u, int wr, int wc, int fr, int fq) const {
        asm volatile("" : "+v"(fr), "+v"(fq));
        const int rbase = u.pm * 256 + wr * 64 + fr, cb = u.pn * 256 + wc * 32 + 8 * fq;
        const float* gp = mod + (size_t)(u.pm >> 4) * NMOD + (MODE == 0 ? 2 * D : 5 * D) + cb;
        f32x4 gv[2][2];
#pragma unroll
        for (int bj = 0; bj < 2; ++bj)
#pragma unroll
            for (int n = 0; n < 2; ++n) gv[bj][n] = *(const f32x4*)(gp + bj * 128 + n * 4);
#pragma unroll
        for (int ai = 0; ai < 2; ++ai)
#pragma unroll
            for (int mp = 0; mp < 4; mp += 2) {
                f32x4 xv[2][2][2];
#pragma unroll
                for (int mm = 0; mm < 2; ++mm)
#pragma unroll
                    for (int bj = 0; bj < 2; ++bj) { const size_t o = (size_t)(rbase + ai * 128 + (mp + mm) * 16) * D + cb + bj * 128;
                        if (MODE == 0) { xv[mm][bj][0] = *(const f32x4*)(xp + o); xv[mm][bj][1] = *(const f32x4*)(xp + o + 4); }
                        else { const u32x4 w = *(const u32x4*)(xb + o); xv[mm][bj][0] = (f32x4){bflo(w.x), bfhi(w.x), bflo(w.y), bfhi(w.y)}; xv[mm][bj][1] = (f32x4){bflo(w.z), bfhi(w.z), bflo(w.w), bfhi(w.w)}; } }
#pragma unroll
                for (int mm = 0; mm < 2; ++mm)
#pragma unroll
                    for (int bj = 0; bj < 2; ++bj) { const size_t o = (size_t)(rbase + ai * 128 + (mp + mm) * 16) * D + cb + bj * 128;
                        *(u32x4*)(xb + o) = pk8(xv[mm][bj][0] + gv[bj][0] * acc[ai][bj][mp + mm][0], xv[mm][bj][1] + gv[bj][1] * acc[ai][bj][mp + mm][1]); }
            }
    }
};
DI void unpack8(const u32x4 w, float (&f)[8]) { f[0] = bflo(w.x); f[1] = bfhi(w.x); f[2] = bflo(w.y); f[3] = bfhi(w.y); f[4] = bflo(w.z); f[5] = bfhi(w.z); f[6] = bflo(w.w); f[7] = bfhi(w.w); }
DI u32x4 shfl4(const u32x4 w, int src) { u32x4 r; r.x = __shfl((int)w.x, src); r.y = __shfl((int)w.y, src); r.z = __shfl((int)w.z, src); r.w = __shfl((int)w.w, src); return r; }
struct EpiUp {
    static constexpr bool PERM = true;
    bf16_t *act, *hup, *hgt, *tup, *ugs; const float *wf, *bfc; float* out;
    DI void operator()(AccRef acc, const Unit& u, int wr, int wc, int fr, int fq) const {
        asm volatile("" : "+v"(fr), "+v"(fq));
        const int ch = u.pn * 128 + wc * 32 + 8 * fq;
        if (u.pm >= MP / 256) {
#pragma unroll
            for (int ai = 0; ai < 2; ++ai)
#pragma unroll
                for (int m = 0; m < 4; ++m) { const int rs = ai * 128 + wr * 64 + m * 16 + fr, i = rs & 31;
                    *(u32x4*)(ugs + (size_t)rs * (2 * DFF) + ch) = pk8(acc[ai][0][m][0], acc[ai][0][m][1]);
                    *(u32x4*)(ugs + (size_t)rs * (2 * DFF) + DFF + ch) = pk8(acc[ai][1][m][0], acc[ai][1][m][1]);
                    if (i >= ST - 2) { float* dst = out + O_FS + ((size_t)(rs >> 5) * 2 + (i - (ST - 2))) * DFF + ch; *(f32x4*)dst = acc[ai][0][m][0]; *(f32x4*)(dst + 4) = acc[ai][0][m][1]; } }
            return;
        }
        const int src1 = fq * 16 + ((fr - 1) & 15), src2 = fq * 16 + ((fr - 2) & 15);
        u32x2 ysave[2][4];
#pragma unroll
        for (int n = 0; n < 2; ++n) {
            const int ch4 = ch + 4 * n;
            const f32x4 w0 = *(const f32x4*)(wf + ch4), w1 = *(const f32x4*)(wf + DFF + ch4), w2 = *(const f32x4*)(wf + 2 * DFF + ch4), bb = *(const f32x4*)(bfc + ch4);
#pragma unroll
            for (int ai = 0; ai < 2; ++ai) {
                const int strip = u.pm * 4 + ai * 2 + wr, row0 = u.pm * 256 + ai * 128 + wr * 64 + fr;
                u32x2 r1p = {0u, 0u}, r2p = {0u, 0u};
#pragma unroll
                for (int m = 0; m < 4; ++m) {
                    const f32x4 ua = acc[ai][0][m][n], ga = acc[ai][1][m][n];
                    u32x2 upk; upk.x = pk2(ua[0], ua[1]); upk.y = pk2(ua[2], ua[3]);
                    u32x2 r1, r2; r1.x = __shfl((int)upk.x, src1); r1.y = __shfl((int)upk.y, src1); r2.x = __shfl((int)upk.x, src2); r2.y = __shfl((int)upk.y, src2);
                    u32x2 q1, q2; q1.x = fr == 0 ? r1p.x : r1.x; q1.y = fr == 0 ? r1p.y : r1.y; q2.x = fr < 2 ? r2p.x : r2.x; q2.y = fr < 2 ? r2p.y : r2.y;
                    r1p = r1; r2p = r2;
                    const f32x4 p1 = {bflo(q1.x), bfhi(q1.x), bflo(q1.y), bfhi(q1.y)}, p2 = {bflo(q2.x), bfhi(q2.x), bflo(q2.y), bfhi(q2.y)};
                    const f32x4 uc = w0 * p2 + w1 * p1 + w2 * ua + bb;
                    f32x4 yv;
#pragma unroll
                    for (int j = 0; j < 4; ++j) yv[j] = ga[j] * uc[j] * __builtin_amdgcn_rcpf(1.0f + __expf(-uc[j]));
                    u32x2 ypk; ypk.x = pk2(yv[0], yv[1]); ypk.y = pk2(yv[2], yv[3]);
                    const int row = row0 + m * 16;
                    if (m == 0 && fr < 2) {
                        u32x2 gpk; gpk.x = pk2(ga[0], ga[1]); gpk.y = pk2(ga[2], ga[3]);
                        *(u32x2*)(hup + ((size_t)strip * 2 + fr) * DFF + ch4) = upk;
                        *(u32x2*)(hgt + ((size_t)strip * 2 + fr) * DFF + ch4) = gpk;
                    } else if (n == 0) ysave[ai][m] = ypk;
                    else { u32x4 w; w.x = ysave[ai][m].x; w.y = ysave[ai][m].y; w.z = ypk.x; w.w = ypk.y; *(u32x4*)(act + (size_t)row * DFF + ch) = w; }
                    if (m == 3 && fr >= 14) {
                        *(u32x2*)(tup + ((size_t)strip * 2 + (fr - 14)) * DFF + ch4) = upk;
                        const int t = row & (T - 1);
                        if (t >= T - 2) *(f32x4*)(out + O_FP + ((size_t)(row >> 12) * 2 + (t - (T - 2))) * DFF + ch4) = ua;
                    }
                }
            }
        }
    }
};

DI int win_srccol(int n) {
    if (n < 2048) return n;
    if (n < 3072) return n + 1024;
    if (n < 5120) { const int j = (n - 3072) >> 8, r = (n - 3072) & 255; return r < 128 ? 4096 + 128 * j + r : 5120 + 128 * j + (r - 128); }
    return n + 1024;
}

DI int wup_srccol(int n) { const int j = n >> 8, r = n & 255; return r < 128 ? 128 * j + r : DFF + 128 * j + (r - 128); }

struct Params {
    const float *x_prompt, *x_sample, *cache_k, *cache_v, *state_conv, *state_ffn, *c_prompt, *c_sample, *w_ada, *b_ada, *g_norm1, *w_in, *w_conv, *b_conv,
                *w_branch_a, *w_branch_b, *w_out, *g_norm2, *w_up, *w_fconv, *b_fconv, *w_down, *g_final;
    float* out; unsigned char* ws;
};

DI void phase_prep(const Params& p, LAS unsigned char* lds, int tid) {
    LAS float* sm = (LAS float*)lds;
    unsigned char* ws = p.ws;
    const int G = gridDim.x, bx = blockIdx.x;
    constexpr int T_WIN = (N1 / 64) * 16, T_WV = 256, T_SQ = 256, T_WUP = (2 * DFF / 64) * 16, T_WDN = 16 * (DFF / 64), T_CV = SB * 256;
    constexpr int E1 = T_WIN, E2 = E1 + T_WV, E3 = E2 + T_SQ, E4 = E3 + T_SQ, E5 = E4 + T_SQ, E6 = E5 + T_WUP, E7 = E6 + T_WDN, E8 = E7 + T_CV;
    constexpr int S_WIN = (N1 / 64) * 4, S_WV = 64, S_SQ = 64, S_WUP = (2 * DFF / 64) * 4, S_WDN = 16 * (DFF / 256), S_CV = SB * 64;
    constexpr int F1 = S_WIN, F2 = F1 + S_WV, F3 = F2 + S_SQ, F4 = F3 + S_SQ, F5 = F4 + S_SQ, F6 = F5 + S_WUP, F7 = F6 + S_WDN, F8 = F7 + S_CV;
#define TILE_DESC(t, src, lds_, dst, ldd) do { \
        if (t < F1) { const int nt = t >> 2, kt = t & 3; src = p.w_in + (size_t)kt * 256 * 8192 + win_srccol(nt * 64); lds_ = 8192; dst = (bf16_t*)(ws + WS_WIN) + (size_t)nt * 64 * D + kt * 256; ldd = D; } \
        else if (t < F2) { const int q = t - F1, nt = q >> 2, kt = q & 3; src = p.w_in + (size_t)kt * 256 * 8192 + 2048 + nt * 64; lds_ = 8192; dst = (bf16_t*)(ws + WS_WV) + (size_t)nt * 64 * D + kt * 256; ldd = D; } \
        else if (t < F5) { const int w = (t - F2) >> 6, q = (t - F2) & 63, nt = q >> 2, kt = q & 3; \
            const float* sb = w == 0 ? p.w_branch_a : (w == 1 ? p.w_branch_b : p.w_out); const size_t off = w == 0 ? WS_WA : (w == 1 ? WS_WB : WS_WO); \
            src = sb + (size_t)kt * 256 * D + nt * 64; lds_ = D; dst = (bf16_t*)(ws + off) + (size_t)nt * 64 * D + kt * 256; ldd = D; } \
        else if (t < F6) { const int q = t - F5, nt = q >> 2, kt = q & 3; src = p.w_up + (size_t)kt * 256 * (2 * DFF) + wup_srccol(nt * 64); lds_ = 2 * DFF; dst = (bf16_t*)(ws + WS_WUP) + (size_t)nt * 64 * D + kt * 256; ldd = D; } \
        else if (t < F7) { const int q = t - F6, nt = q / (DFF / 256), kt = q % (DFF / 256); src = p.w_down + (size_t)kt * 256 * D + nt * 64; lds_ = D; dst = (bf16_t*)(ws + WS_WDN) + (size_t)nt * 64 * DFF + kt * 256; ldd = DFF; } \
        else { const int q = t - F7, b = q >> 6, nt = (q >> 2) & 15, kt = q & 3; \
            src = p.cache_v + (size_t)b * PAST * D + (size_t)kt * 256 * D + nt * 64; lds_ = D; dst = (bf16_t*)(ws + WS_VTS) + (((size_t)b * NH + nt) * (SKV / 32) + kt * 8) * 2048; ldd = -1; } } while (0)
    {
        const int c4 = tid & 15, kk0 = tid >> 4;
        for (int t = bx; t < F8; t += G) {
            const float* src; int lds_; bf16_t* dst; int ldd;
            TILE_DESC(t, src, lds_, dst, ldd);
            f32x4 rv[8];
#pragma unroll
            for (int i = 0; i < 8; ++i) rv[i] = *(const f32x4*)(src + (size_t)(kk0 + 32 * i) * lds_ + c4 * 4);
#pragma unroll
            for (int i = 0; i < 8; ++i)
#pragma unroll
                for (int j = 0; j < 4; ++j) sm[(c4 * 4 + j) * 257 + kk0 + 32 * i] = rv[i][j];
            __syncthreads();
#pragma unroll
            for (int i = 0; i < 4; ++i) { const int n = (tid >> 5) + 16 * i, k8 = (tid & 31) * 8; const LAS float* s2 = sm + n * 257 + k8;
              u32x4 w; w.x = pk2(s2[0], s2[1]); w.y = pk2(s2[2], s2[3]); w.z = pk2(s2[4], s2[5]); w.w = pk2(s2[6], s2[7]);
              if (ldd > 0) *(u32x4*)(dst + (size_t)n * ldd + k8) = w;
              else { bf16_t* vd = dst + (size_t)(k8 >> 5) * 2048 + n * 32 + ((k8 & 31) >> 3) * 4; u32x2 a; a.x = w.x; a.y = w.y; u32x2 b2; b2.x = w.z; b2.y = w.w; *(u32x2*)vd = a; *(u32x2*)(vd + 16) = b2; } }
            __syncthreads();
        }
    }
#undef TILE_DESC
    { bf16_t* ks = (bf16_t*)(ws + WS_KS);
      for (size_t i = (size_t)bx * 512 + tid; i < (size_t)SB * PAST * D / 8; i += (size_t)G * 512) {
          const size_t e = i * 8; const int b = (int)(e / ((size_t)PAST * D)); const size_t r = e % ((size_t)PAST * D);
          const f32x4 a = *(const f32x4*)(p.cache_k + e), c = *(const f32x4*)(p.cache_k + e + 4);
          const int pos = (int)(r >> 10), hh = (int)(r >> 6) & 15, dd = (int)r & 63;
          *(u32x4*)(ks + (((size_t)b * NH + hh) * SKV + pos) * HD + dd) = pk8(a, c); } }
    for (int job = bx; job < NMOD / 32; job += G) {
        __syncthreads();
        for (int i = tid; i < 24 * D; i += 512) { const int r = i >> 10, k = i & 1023; const float c = r < 16 ? p.c_prompt[r * D + k] : p.c_sample[(r - 16) * D + k]; sm[i] = c / (1.0f + __expf(-c)); }
        __syncthreads();
        const int n = tid & 31, kq = tid >> 5, col = job * 32 + n;
        float a[24];
#pragma unroll
        for (int r = 0; r < 24; ++r) a[r] = 0.f;
        for (int k0 = kq * 64; k0 < kq * 64 + 64; k0 += 16) { float wv[16];
#pragma unroll
            for (int kk = 0; kk < 16; ++kk) wv[kk] = p.w_ada[(size_t)(k0 + kk) * NMOD + col];
#pragma unroll
            for (int kk = 0; kk < 16; ++kk)
#pragma unroll
                for (int r = 0; r < 24; ++r) a[r] += sm[r * D + k0 + kk] * wv[kk]; }
        __syncthreads();
#pragma unroll
        for (int r = 0; r < 24; ++r) sm[(kq * 24 + r) * 32 + n] = a[r];
        __syncthreads();
        for (int i = tid; i < 24 * 32; i += 512) { const int r = i >> 5, nn = i & 31; float s = p.b_ada[job * 32 + nn];
            for (int q = 0; q < 16; ++q) s += sm[(q * 24 + r) * 32 + nn];
            ((float*)(ws + WS_MOD))[(size_t)r * NMOD + job * 32 + nn] = s; }
    }
    __syncthreads();
}

DI void phase_norm_mod(const float* srcP, const float* srcS, const float* g, const float* mod, int shift_off, bf16_t* dst, int gw, int nw, int lane) {
    f32x4 gv[4];
#pragma unroll
    for (int i = 0; i < 4; ++i) gv[i] = *(const f32x4*)(g + lane * 4 + 256 * i);
    f32x4 cur[2][4], nxt[2][4];
#define NM_LOAD(dstv, r0) do { _Pragma("unroll") for (int rr = 0; rr < 2; ++rr) { const int row_ = (r0) + rr * nw; if (row_ < M) { \
        const float* s_ = row_ < MP ? srcP + (size_t)row_ * D : srcS + (size_t)(row_ - MP) * D; \
        _Pragma("unroll") for (int i = 0; i < 4; ++i) dstv[rr][i] = *(const f32x4*)(s_ + lane * 4 + 256 * i); } } } while (0)
    NM_LOAD(cur, gw);
    for (int row0 = gw; row0 < M; row0 += 2 * nw) {
        NM_LOAD(nxt, row0 + 2 * nw);
        f32x4 msh[4], msc[4];
        { const float* mp = mod + (size_t)bidx_of(row0) * NMOD + shift_off;
#pragma unroll
          for (int i = 0; i < 4; ++i) { const int c = lane * 4 + 256 * i; msh[i] = *(const f32x4*)(mp + c); msc[i] = *(const f32x4*)(mp + D + c); } }
#pragma unroll
        for (int rr = 0; rr < 2; ++rr) { const int row = row0 + rr * nw; if (row < M) {
            float ss = 0.f;
#pragma unroll
            for (int i = 0; i < 4; ++i) ss += cur[rr][i][0] * cur[rr][i][0] + cur[rr][i][1] * cur[rr][i][1] + cur[rr][i][2] * cur[rr][i][2] + cur[rr][i][3] * cur[rr][i][3];
#pragma unroll
            for (int o = 32; o >= 1; o >>= 1) ss += __shfl_xor(ss, o);
            const float rstd = rsqrtf(ss * (1.0f / D) + 1e-6f);
            if (rr == 1 && bidx_of(row) != bidx_of(row0)) { const float* mp = mod + (size_t)bidx_of(row) * NMOD + shift_off;
#pragma unroll
                for (int i = 0; i < 4; ++i) { const int c = lane * 4 + 256 * i; msh[i] = *(const f32x4*)(mp + c); msc[i] = *(const f32x4*)(mp + D + c); } }
#pragma unroll
            for (int i = 0; i < 4; ++i) { const int c = lane * 4 + 256 * i; const f32x4 sh = msh[i], sc = msc[i];
                const f32x4 h = cur[rr][i] * rstd * gv[i] * (sc + 1.0f) + sh;
                u32x2 w; w.x = pk2(h[0], h[1]); w.y = pk2(h[2], h[3]); *(u32x2*)(dst + (size_t)row * D + c) = w; } } }
#pragma unroll
        for (int rr = 0; rr < 2; ++rr)
#pragma unroll
            for (int i = 0; i < 4; ++i) cur[rr][i] = nxt[rr][i];
    }
#undef NM_LOAD
}
DI void phase_final_norm(float* y, const float* g, int gw, int nw, int lane) {
    f32x4 gv[4];
#pragma unroll
    for (int i = 0; i < 4; ++i) gv[i] = *(const f32x4*)(g + lane * 4 + 256 * i);
    f32x4 cur[2][4], nxt[2][4];
#define NM_LOAD(dstv, r0) do { _Pragma("unroll") for (int rr = 0; rr < 2; ++rr) { const int row_ = (r0) + rr * nw; if (row_ < M) { \
        const float* s_ = y + (size_t)row_ * D; \
        _Pragma("unroll") for (int i = 0; i < 4; ++i) dstv[rr][i] = *(const f32x4*)(s_ + lane * 4 + 256 * i); } } } while (0)
    NM_LOAD(cur, gw);
    for (int row0 = gw; row0 < M; row0 += 2 * nw) {
        NM_LOAD(nxt, row0 + 2 * nw);
#pragma unroll
        for (int rr = 0; rr < 2; ++rr) { const int row = row0 + rr * nw; if (row < M) {
            float ss = 0.f;
#pragma unroll
            for (int i = 0; i < 4; ++i) ss += cur[rr][i][0] * cur[rr][i][0] + cur[rr][i][1] * cur[rr][i][1] + cur[rr][i][2] * cur[rr][i][2] + cur[rr][i][3] * cur[rr][i][3];
#pragma unroll
            for (int o = 32; o >= 1; o >>= 1) ss += __shfl_xor(ss, o);
            const float rstd = rsqrtf(ss * (1.0f / D) + 1e-6f);
#pragma unroll
            for (int i = 0; i < 4; ++i) *(f32x4*)(y + (size_t)row * D + lane * 4 + 256 * i) = cur[rr][i] * rstd * gv[i]; } }
#pragma unroll
        for (int rr = 0; rr < 2; ++rr)
#pragma unroll
            for (int i = 0; i < 4; ++i) cur[rr][i] = nxt[rr][i];
    }
#undef NM_LOAD
}

template <int MODE> DI void phase_norm_b(const bf16_t* src, const float* g, const float* mod, int shift_off, bf16_t* dst, float* dstf, int gw, int nw, int lane) {
    f32x4 gv[4];
#pragma unroll
    for (int i = 0; i < 2; ++i) { gv[2 * i] = *(const f32x4*)(g + lane * 8 + 512 * i); gv[2 * i + 1] = *(const f32x4*)(g + lane * 8 + 512 * i + 4); }
    u32x4 cur[4][2], nxt[4][2];
#define NB_LOAD(dstv, r0) do { _Pragma("unroll") for (int rr = 0; rr < 4; ++rr) { const int row_ = (r0) + rr * nw; if (row_ < M) { \
        _Pragma("unroll") for (int i = 0; i < 2; ++i) dstv[rr][i] = *(const u32x4*)(src + (size_t)row_ * D + lane * 8 + 512 * i); } } } while (0)
    NB_LOAD(cur, gw);
    for (int row0 = gw; row0 < M; row0 += 4 * nw) {
        NB_LOAD(nxt, row0 + 4 * nw);
        f32x4 msh[2][4], msc[2][4];
        if (MODE == 0) {
#pragma unroll
            for (int pr = 0; pr < 2; ++pr) { const int row_ = row0 + 2 * pr * nw; if (row_ < M) { const float* mp = mod + (size_t)bidx_of(row_) * NMOD + shift_off;
#pragma unroll
                for (int i = 0; i < 2; ++i) { const int c = lane * 8 + 512 * i; msh[pr][2 * i] = *(const f32x4*)(mp + c); msh[pr][2 * i + 1] = *(const f32x4*)(mp + c + 4); msc[pr][2 * i] = *(const f32x4*)(mp + D + c); msc[pr][2 * i + 1] = *(const f32x4*)(mp + D + c + 4); } } }
        }
#pragma unroll
        for (int rr = 0; rr < 4; ++rr) { const int row = row0 + rr * nw; if (row < M) {
            f32x4 v[4];
#pragma unroll
            for (int i = 0; i < 2; ++i) { const u32x4 w = cur[rr][i]; v[2 * i] = (f32x4){bflo(w.x), bfhi(w.x), bflo(w.y), bfhi(w.y)}; v[2 * i + 1] = (f32x4){bflo(w.z), bfhi(w.z), bflo(w.w), bfhi(w.w)}; }
            float ss = 0.f;
#pragma unroll
            for (int i = 0; i < 4; ++i) ss += v[i][0] * v[i][0] + v[i][1] * v[i][1] + v[i][2] * v[i][2] + v[i][3] * v[i][3];
#pragma unroll
            for (int o = 32; o >= 1; o >>= 1) ss += __shfl_xor(ss, o);
            const float rstd = rsqrtf(ss * (1.0f / D) + 1e-6f);
            if (MODE == 0) {
                if ((rr & 1) && bidx_of(row) != bidx_of(row - nw)) {
                    const float* mp = mod + (size_t)bidx_of(row) * NMOD + shift_off;
#pragma unroll
                    for (int i = 0; i < 2; ++i) { const int c = lane * 8 + 512 * i; msh[rr >> 1][2 * i] = *(const f32x4*)(mp + c); msh[rr >> 1][2 * i + 1] = *(const f32x4*)(mp + c + 4); msc[rr >> 1][2 * i] = *(const f32x4*)(mp + D + c); msc[rr >> 1][2 * i + 1] = *(const f32x4*)(mp + D + c + 4); } }
#pragma unroll
                for (int i = 0; i < 2; ++i) { const int c = lane * 8 + 512 * i;
                    const f32x4 h0 = v[2 * i] * rstd * gv[2 * i] * (msc[rr >> 1][2 * i] + 1.0f) + msh[rr >> 1][2 * i];
                    const f32x4 h1 = v[2 * i + 1] * rstd * gv[2 * i + 1] * (msc[rr >> 1][2 * i + 1] + 1.0f) + msh[rr >> 1][2 * i + 1];
                    *(u32x4*)(dst + (size_t)row * D + c) = pk8(h0, h1); }
            } else {
#pragma unroll
                for (int i = 0; i < 2; ++i) { const int c = lane * 8 + 512 * i;
                    *(f32x4*)(dstf + (size_t)row * D + c) = v[2 * i] * rstd * gv[2 * i]; *(f32x4*)(dstf + (size_t)row * D + c + 4) = v[2 * i + 1] * rstd * gv[2 * i + 1]; }
            } } }
#pragma unroll
        for (int rr = 0; rr < 4; ++rr)
#pragma unroll
            for (int i = 0; i < 2; ++i) cur[rr][i] = nxt[rr][i];
    }
#undef NB_LOAD
}

DI void phase_ob(const Params& p, bf16_t* bg, const bf16_t* cu, int gw, int nw, int lane) {
    for (int item = gw; item < (M / 16) * 2; item += nw) {
        const int half = item & 1, row0 = (item >> 1) * 16, ch = half * 512 + lane * 8;
        float w0[8], w1[8], w2[8], bb[8], p2[8], p1[8];
#pragma unroll
        for (int j = 0; j < 8; ++j) { w0[j] = p.w_conv[ch + j]; w1[j] = p.w_conv[D + ch + j]; w2[j] = p.w_conv[2 * D + ch + j]; bb[j] = p.b_conv[ch + j]; }
        const bool start = row0 < MP ? ((row0 & (T - 1)) == 0) : (((row0 - MP) & 31) == 0);
        if (start) {
            if (row0 < MP) {
#pragma unroll
                for (int j = 0; j < 8; ++j) { p2[j] = 0.f; p1[j] = 0.f; } }
            else { const float* sc = p.state_conv + (size_t)((row0 - MP) >> 5) * 2 * D + ch;
#pragma unroll
                for (int j = 0; j < 8; ++j) { p2[j] = sc[j]; p1[j] = sc[D + j]; } }
        } else {
            const u32x4 a = *(const u32x4*)(cu + (size_t)(row0 - 2) * D + ch), b = *(const u32x4*)(cu + (size_t)(row0 - 1) * D + ch);
            p2[0] = bflo(a.x); p2[1] = bfhi(a.x); p2[2] = bflo(a.y); p2[3] = bfhi(a.y); p2[4] = bflo(a.z); p2[5] = bfhi(a.z); p2[6] = bflo(a.w); p2[7] = bfhi(a.w);
            p1[0] = bflo(b.x); p1[1] = bfhi(b.x); p1[2] = bflo(b.y); p1[3] = bfhi(b.y); p1[4] = bflo(b.z); p1[5] = bfhi(b.z); p1[6] = bflo(b.w); p1[7] = bfhi(b.w);
        }
#pragma unroll
        for (int rb = 0; rb < 16; rb += 8) {
            u32x4 cc[8], gq[8];
#pragma unroll
            for (int r = 0; r < 8; ++r) { const size_t o = (size_t)(row0 + rb + r) * D + ch; cc[r] = *(const u32x4*)(cu + o); gq[r] = *(const u32x4*)(bg + o); }
#pragma unroll
            for (int r = 0; r < 8; ++r) {
                const u32x4 c = cc[r], q4 = gq[r];
                float cur[8] = {bflo(c.x), bfhi(c.x), bflo(c.y), bfhi(c.y), bflo(c.z), bfhi(c.z), bflo(c.w), bfhi(c.w)};
                float gg[8] = {bflo(q4.x), bfhi(q4.x), bflo(q4.y), bfhi(q4.y), bflo(q4.z), bfhi(q4.z), bflo(q4.w), bfhi(q4.w)};
                float y[8];
#pragma unroll
                for (int j = 0; j < 8; ++j) { y[j] = gg[j] * (w0[j] * p2[j] + w1[j] * p1[j] + w2[j] * cur[j] + bb[j]); p2[j] = p1[j]; p1[j] = cur[j]; }
                u32x4 w; w.x = pk2(y[0], y[1]); w.y = pk2(y[2], y[3]); w.z = pk2(y[4], y[5]); w.w = pk2(y[6], y[7]);
                *(u32x4*)(bg + (size_t)(row0 + rb + r) * D + ch) = w;
            }
        }
    }
}
DI void phase_act_fix(const Params& p, bf16_t* act, const bf16_t* hup, const bf16_t* hgt, const bf16_t* tup, const bf16_t* ugs, int gw, int nw, int lane) {
    constexpr int NSTRIP = MP / 64, NFIX = NSTRIP * 6, NSMP = (MS / 16) * 11;
    for (int item = gw; item < NFIX + NSMP; item += nw) {
        if (item < NFIX) {
            const int strip = item / 6, slab = item % 6, ch = slab * 512 + lane * 8;
            if (ch >= DFF) continue;
            float w0[8], w1[8], w2[8], bb[8], p2[8], p1[8], c0[8], c1[8], g0[8], g1[8];
#pragma unroll
            for (int j = 0; j < 8; ++j) { w0[j] = p.w_fconv[ch + j]; w1[j] = p.w_fconv[DFF + ch + j]; w2[j] = p.w_fconv[2 * DFF + ch + j]; bb[j] = p.b_fconv[ch + j]; }
            if ((strip & 63) == 0) {
#pragma unroll
                for (int j = 0; j < 8; ++j) { p2[j] = 0.f; p1[j] = 0.f; } }
            else { unpack8(*(const u32x4*)(tup + ((size_t)(strip - 1) * 2) * DFF + ch), p2); unpack8(*(const u32x4*)(tup + ((size_t)(strip - 1) * 2 + 1) * DFF + ch), p1); }
            unpack8(*(const u32x4*)(hup + ((size_t)strip * 2) * DFF + ch), c0); unpack8(*(const u32x4*)(hup + ((size_t)strip * 2 + 1) * DFF + ch), c1);
            unpack8(*(const u32x4*)(hgt + ((size_t)strip * 2) * DFF + ch), g0); unpack8(*(const u32x4*)(hgt + ((size_t)strip * 2 + 1) * DFF + ch), g1);
            float y0[8], y1[8];
#pragma unroll
            for (int j = 0; j < 8; ++j) { const float ua = w0[j] * p2[j] + w1[j] * p1[j] + w2[j] * c0[j] + bb[j], ub = w0[j] * p1[j] + w1[j] * c0[j] + w2[j] * c1[j] + bb[j];
                y0[j] = g0[j] * ua / (1.0f + __expf(-ua)); y1[j] = g1[j] * ub / (1.0f + __expf(-ub)); }
            u32x4 a, b; a.x = pk2(y0[0], y0[1]); a.y = pk2(y0[2], y0[3]); a.z = pk2(y0[4], y0[5]); a.w = pk2(y0[6], y0[7]);
            b.x = pk2(y1[0], y1[1]); b.y = pk2(y1[2], y1[3]); b.z = pk2(y1[4], y1[5]); b.w = pk2(y1[6], y1[7]);
            *(u32x4*)(act + (size_t)(strip * 64) * DFF + ch) = a; *(u32x4*)(act + (size_t)(strip * 64 + 1) * DFF + ch) = b;
        } else {
            const int q = item - NFIX, slab = q % 11, row0 = (q / 11) * 16, ch = slab * 256 + lane * 4;
            float w0[4], w1[4], w2[4], bb[4], p2[4], p1[4];
#pragma unroll
            for (int j = 0; j < 4; ++j) { w0[j] = p.w_fconv[ch + j]; w1[j] = p.w_fconv[DFF + ch + j]; w2[j] = p.w_fconv[2 * DFF + ch + j]; bb[j] = p.b_fconv[ch + j]; }
            if ((row0 & 31) == 0) { const float* sc = p.state_ffn + (size_t)(row0 >> 5) * 2 * DFF + ch;
#pragma unroll
                for (int j = 0; j < 4; ++j) { p2[j] = sc[j]; p1[j] = sc[DFF + j]; } }
            else { const u32x2 a = *(const u32x2*)(ugs + (size_t)(row0 - 2) * (2 * DFF) + ch), b = *(const u32x2*)(ugs + (size_t)(row0 - 1) * (2 * DFF) + ch);
                p2[0] = bflo(a.x); p2[1] = bfhi(a.x); p2[2] = bflo(a.y); p2[3] = bfhi(a.y); p1[0] = bflo(b.x); p1[1] = bfhi(b.x); p1[2] = bflo(b.y); p1[3] = bfhi(b.y); }
            u32x2 cc[16], gq[16];
#pragma unroll
            for (int r = 0; r < 16; ++r) { const size_t o = (size_t)(row0 + r) * (2 * DFF) + ch; cc[r] = *(const u32x2*)(ugs + o); gq[r] = *(const u32x2*)(ugs + o + DFF); }
#pragma unroll
            for (int r = 0; r < 16; ++r) {
                const u32x2 c = cc[r], q2 = gq[r];
                float cur[4] = {bflo(c.x), bfhi(c.x), bflo(c.y), bfhi(c.y)};
                float gg[4] = {bflo(q2.x), bfhi(q2.x), bflo(q2.y), bfhi(q2.y)};
                float y[4];
#pragma unroll
                for (int j = 0; j < 4; ++j) { const float uc = w0[j] * p2[j] + w1[j] * p1[j] + w2[j] * cur[j] + bb[j]; y[j] = gg[j] * uc / (1.0f + __expf(-uc)); p2[j] = p1[j]; p1[j] = cur[j]; }
                u32x2 w; w.x = pk2(y[0], y[1]); w.y = pk2(y[2], y[3]);
                *(u32x2*)(act + (size_t)(MP + row0 + r) * DFF + ch) = w;
            }
        }
    }
}


#define MFMA32(a, b, c) __builtin_amdgcn_mfma_f32_32x32x16_bf16((a), (b), (c), 0, 0, 0)
DI void sg_mma(f32x16& acc, const bf16_t* X, int ldx, const bf16_t* Y, int ldy, int K, int lane) {
    const bf16_t* xp = X + (size_t)(lane & 31) * ldx + 8 * (lane >> 5);
    const bf16_t* yp = Y + (size_t)(lane & 31) * ldy + 8 * (lane >> 5);
    for (int k0 = 0; k0 < K; k0 += 128) {
        bf16x8 xa[8], yb[8];
#pragma unroll
        for (int s2 = 0; s2 < 8; ++s2) { xa[s2] = *(const bf16x8*)(xp + k0 + 16 * s2); yb[s2] = *(const bf16x8*)(yp + k0 + 16 * s2); }
#pragma unroll
        for (int s2 = 0; s2 < 8; ++s2) acc = MFMA32(xa[s2], yb[s2], acc);
    }
}
DI f32x16 zero16() { f32x16 z;
#pragma unroll
    for (int e = 0; e < 16; ++e) z[e] = 0.f; return z; }
DI void st_bf4(bf16_t* p, float a, float b, float c, float d) { u32x2 w; w.x = pk2(a, b); w.y = pk2(c, d); *(u32x2*)p = w; }

DI void sample_p2(const bf16_t* hbuf, const bf16_t* Win, const bf16_t* Wv, bf16_t* q, bf16_t* ks, bf16_t* vts, bf16_t* bg, bf16_t* cu, bf16_t* sga, bf16_t* sgb, float* out, int gw, int lane) {
    if (gw >= 7 * 256) return;
    const int kind = gw >> 8, b = (gw >> 5) & 7, j = gw & 31, hf = lane >> 5, tl = lane & 31;
    const bf16_t* hrow = hbuf + (size_t)(MP + 32 * b) * D;
    const int row = MP + 32 * b + tl, rs = 32 * b + tl;
    if (kind == 6) {
        f32x16 acc = zero16(); sg_mma(acc, hrow, D, Wv + (size_t)(32 * j) * D, D, D, lane);
        const int dch = 32 * j + tl, hh = dch >> 6, dd = dch & 63;
#pragma unroll
        for (int g = 0; g < 4; ++g) {
            st_bf4(vts + (((size_t)b * NH + hh) * (SKV / 32) + PAST / 32) * 2048 + dd * 32 + 16 * hf + 4 * g, acc[4 * g], acc[4 * g + 1], acc[4 * g + 2], acc[4 * g + 3]);
#pragma unroll
            for (int e = 0; e < 4; ++e) out[O_VS + (size_t)(32 * b + 8 * g + 4 * hf + e) * D + dch] = acc[4 * g + e];
        }
        return;
    }
    if (kind == 3) {
        const int c0 = 32 * j, vC = 3072 + 256 * (c0 >> 7) + (c0 & 127);
        f32x16 aC = zero16(), aU = zero16();
        sg_mma(aC, Win + (size_t)vC * D, D, hrow, D, D, lane); sg_mma(aU, Win + (size_t)(vC + 128) * D, D, hrow, D, D, lane);
#pragma unroll
        for (int g = 0; g < 4; ++g) { const int c = c0 + 8 * g + 4 * hf; f32x4 pr = {aC[4 * g] * aU[4 * g], aC[4 * g + 1] * aU[4 * g + 1], aC[4 * g + 2] * aU[4 * g + 2], aC[4 * g + 3] * aU[4 * g + 3]};
            st_bf4(cu + (size_t)row * D + c, pr[0], pr[1], pr[2], pr[3]);
            if (tl >= ST - 2) *(f32x4*)(out + O_CS + ((size_t)b * 2 + (tl - (ST - 2))) * D + c) = pr; }
        return;
    }
    const int vbase = kind == 0 ? 0 : (kind == 1 ? 1024 : (kind == 2 ? 2048 : (kind == 4 ? 5120 : 6144)));
    f32x16 acc = zero16(); sg_mma(acc, Win + (size_t)(vbase + 32 * j) * D, D, hrow, D, D, lane);
#pragma unroll
    for (int g = 0; g < 4; ++g) { const int n = 32 * j + 8 * g + 4 * hf; const float a0 = acc[4 * g], a1 = acc[4 * g + 1], a2 = acc[4 * g + 2], a3 = acc[4 * g + 3];
        if (kind == 0) st_bf4(q + (size_t)row * D + n, a0 * QSCALE, a1 * QSCALE, a2 * QSCALE, a3 * QSCALE);
        else if (kind == 1) { st_bf4(ks + (((size_t)b * NH + (n >> 6)) * SKV + PAST + tl) * HD + (n & 63), a0, a1, a2, a3); *(f32x4*)(out + O_KS + (size_t)rs * D + n) = (f32x4){a0, a1, a2, a3}; }
        else if (kind == 2) st_bf4(bg + (size_t)row * D + n, a0, a1, a2, a3);
        else st_bf4((kind == 4 ? sga : sgb) + (size_t)row * D + n, sigmoidf_(a0), sigmoidf_(a1), sigmoidf_(a2), sigmoidf_(a3)); }
}
DI void sample_p4(const bf16_t* oa, const bf16_t* ob, const bf16_t* Wa, const bf16_t* Wb, const bf16_t* sga, const bf16_t* sgb, bf16_t* merged, int job, int lane) {
    const int b = job >> 5, j = job & 31, hf = lane >> 5, tl = lane & 31, row = MP + 32 * b + tl;
    f32x16 aA = zero16(), aB = zero16();
    sg_mma(aA, Wa + (size_t)(32 * j) * D, D, oa + (size_t)(MP + 32 * b) * D, D, D, lane); sg_mma(aB, Wb + (size_t)(32 * j) * D, D, ob + (size_t)(MP + 32 * b) * D, D, D, lane);
#pragma unroll
    for (int g = 0; g < 4; ++g) { const size_t o = (size_t)row * D + 32 * j + 8 * g + 4 * hf; const u32x2 sa = *(const u32x2*)(sga + o), sb = *(const u32x2*)(sgb + o);
        st_bf4(merged + o, bflo(sa.x) * aA[4 * g] + bflo(sb.x) * aB[4 * g], bfhi(sa.x) * aA[4 * g + 1] + bfhi(sb.x) * aB[4 * g + 1],
               bflo(sa.y) * aA[4 * g + 2] + bflo(sb.y) * aB[4 * g + 2], bfhi(sa.y) * aA[4 * g + 3] + bfhi(sb.y) * aB[4 * g + 3]); }
}
template <int MODE> DI void sample_res(const bf16_t* A, int lda, const bf16_t* W, int K, const float* xs, const float* gate, bf16_t* xb, int job, int lane) {
    const int b = job >> 5, j = job & 31, hf = lane >> 5, tl = lane & 31;
    f32x16 acc = zero16(); sg_mma(acc, W + (size_t)(32 * j) * K, K, A + (size_t)(MP + 32 * b) * lda, lda, K, lane);
    const float* gp = gate + (size_t)(16 + b) * NMOD;
#pragma unroll
    for (int g = 0; g < 4; ++g) { const int n = 32 * j + 8 * g + 4 * hf; const f32x4 a = {acc[4 * g], acc[4 * g + 1], acc[4 * g + 2], acc[4 * g + 3]};
        bf16_t* dp = xb + (size_t)(MP + 32 * b + tl) * D + n; f32x4 x;
        if (MODE == 0) x = *(const f32x4*)(xs + (size_t)(32 * b + tl) * D + n);
        else { const u32x2 w = *(const u32x2*)dp; x = (f32x4){bflo(w.x), bfhi(w.x), bflo(w.y), bfhi(w.y)}; }
        const f32x4 r = x + *(const f32x4*)(gp + n) * a; st_bf4(dp, r[0], r[1], r[2], r[3]); }
}
DI void sample_up(const bf16_t* h2, const bf16_t* Wup, bf16_t* ugs, float* out, int gw, int lane) {
    if (gw >= 1408) return;
    const int isg = gw >= 704 ? 1 : 0, r = gw - 704 * isg, b = r / 88, j = r % 88, hf = lane >> 5, tl = lane & 31, c0 = 32 * j;
    const int vrow = 256 * (c0 >> 7) + (c0 & 127) + 128 * isg;
    f32x16 acc = zero16(); sg_mma(acc, Wup + (size_t)vrow * D, D, h2 + (size_t)(MP + 32 * b) * D, D, D, lane);
#pragma unroll
    for (int g = 0; g < 4; ++g) { const int c = c0 + 8 * g + 4 * hf;
        st_bf4(ugs + (size_t)(32 * b + tl) * (2 * DFF) + DFF * isg + c, acc[4 * g], acc[4 * g + 1], acc[4 * g + 2], acc[4 * g + 3]);
        if (!isg && tl >= ST - 2) *(f32x4*)(out + O_FS + ((size_t)b * 2 + (tl - (ST - 2))) * DFF + c) = (f32x4){acc[4 * g], acc[4 * g + 1], acc[4 * g + 2], acc[4 * g + 3]}; }
}

DI void phase_attn(bf16_t* qo, const bf16_t* kbuf, const bf16_t* vT, const bf16_t* ks, const bf16_t* vts, LAS unsigned char* lds, int wid, int gw, int nw, int lane) {
    const int hf = lane >> 5, tl = lane & 31;
    LAS unsigned char* myl = lds + wid * (32 * 144);
    constexpr int NITEM = NB * NH * (T / 32) + SB * NH;
    for (int item = gw; item < NITEM; item += nw) {
        int qt, h, qrow0; const bf16_t *K, *VT;
        if (item < NB * NH * (T / 32)) { qt = item & 127; h = (item >> 7) & 15; const int b = item >> 11; qrow0 = b * T + qt * 32;
            K = kbuf + ((size_t)(b * NH + h) * T) * HD; VT = vT + ((size_t)(b * NH + h) * (T / 32)) * 2048; }
        else { const int s = item - NB * NH * (T / 32); h = s & 15; const int b = s >> 4; qt = PAST / 32; qrow0 = MP + b * ST;
            K = ks + ((size_t)(b * NH + h) * SKV) * HD; VT = vts + ((size_t)(b * NH + h) * (SKV / 32)) * 2048; }
        bf16x8 qf[4];
        { const bf16_t* qp = qo + (size_t)(qrow0 + tl) * D + h * HD + 8 * hf;
#pragma unroll
          for (int s = 0; s < 4; ++s) qf[s] = *(const bf16x8*)(qp + 16 * s); }
        f32x16 O0, O1;
#pragma unroll
        for (int e = 0; e < 16; ++e) { O0[e] = 0.f; O1[e] = 0.f; }
        float carry = 0.f;
        bf16x8 kfA[4], vrA[2][2], kfB[4], vrB[2][2];
#define AT_LOAD(kfd, vrd, kb_) do { const bf16_t* kp_ = K + (size_t)((kb_) * 32 + tl) * HD + 8 * hf; const bf16_t* vp_ = VT + (size_t)(kb_) * 2048 + tl * 32 + hf * 16; \
        _Pragma("unroll") for (int s = 0; s < 4; ++s) kfd[s] = *(const bf16x8*)(kp_ + 16 * s); \
        _Pragma("unroll") for (int dt = 0; dt < 2; ++dt) _Pragma("unroll") for (int s = 0; s < 2; ++s) vrd[dt][s] = *(const bf16x8*)(vp_ + dt * 1024 + s * 8); } while (0)
#define AT_BLOCK(kf, vr, kfn, vrn, kb_, done_) do { \
            if ((kb_) > 0) AT_LOAD(kfn, vrn, (kb_) - 1); \
            f32x16 z = MFMA32(kf[0], qf[0], zc); \
            _Pragma("unroll") for (int s = 1; s < 4; ++s) z = MFMA32(kf[s], qf[s], z); \
            const bool diag = ((kb_) == qt); \
            float L[16]; \
            _Pragma("unroll") for (int e = 0; e < 16; ++e) { const float zz = z[e]; const float ex = __builtin_amdgcn_exp2f(-fabsf(zz)); \
                float l = -(__builtin_amdgcn_fmed3f(zz, 0.f, __builtin_inff()) + __builtin_amdgcn_logf(1.0f + ex)); \
                if (diag) { const int key = 8 * (e >> 2) + 4 * hf + (e & 3); if (key >= tl) l = 0.f; } \
                L[e] = l; } \
            float Gs[4], Gp[4]; \
            _Pragma("unroll") for (int g = 0; g < 4; ++g) { Gs[g] = (L[4 * g] + L[4 * g + 1]) + (L[4 * g + 2] + L[4 * g + 3]); Gp[g] = __shfl_xor(Gs[g], 32); } \
            float Tt[5]; Tt[4] = 0.f; \
            _Pragma("unroll") for (int g = 3; g >= 0; --g) Tt[g] = Tt[g + 1] + (Gs[g] + Gp[g]); \
            float a[16]; \
            _Pragma("unroll") for (int g = 0; g < 4; ++g) { \
                const float s3 = Tt[g + 1] + (hf == 0 ? Gp[g] : 0.f) + carry; \
                const float s2 = s3 + L[4 * g + 3], s1 = s2 + L[4 * g + 2], s0 = s1 + L[4 * g + 1]; \
                a[4 * g + 3] = __builtin_amdgcn_exp2f(z[4 * g + 3] + L[4 * g + 3] + s3); a[4 * g + 2] = __builtin_amdgcn_exp2f(z[4 * g + 2] + L[4 * g + 2] + s2); \
                a[4 * g + 1] = __builtin_amdgcn_exp2f(z[4 * g + 1] + L[4 * g + 1] + s1); a[4 * g] = __builtin_amdgcn_exp2f(z[4 * g] + L[4 * g] + s0); } \
            if (diag) { _Pragma("unroll") for (int e = 0; e < 16; ++e) { const int key = 8 * (e >> 2) + 4 * hf + (e & 3); if (key >= tl) a[e] = 0.f; } } \
            carry += Tt[0]; \
            _Pragma("unroll") for (int s = 0; s < 2; ++s) { \
                u32x4 aw; aw.x = pk2(a[8 * s], a[8 * s + 1]); aw.y = pk2(a[8 * s + 2], a[8 * s + 3]); aw.z = pk2(a[8 * s + 4], a[8 * s + 5]); aw.w = pk2(a[8 * s + 6], a[8 * s + 7]); \
                const bf16x8 af = __builtin_bit_cast(bf16x8, aw); \
                O0 = MFMA32(vr[0][s], af, O0); O1 = MFMA32(vr[1][s], af, O1); } \
              \
            done_ = ((kb_) == 0) || __all(carry < -151.0f); } while (0)
        const f32x16 zc = zero16();
        AT_LOAD(kfA, vrA, qt);
        for (int kb = qt; kb >= 0; kb -= 2) {
            bool done;
            AT_BLOCK(kfA, vrA, kfB, vrB, kb, done);
            if (done) break;
            AT_BLOCK(kfB, vrB, kfA, vrA, kb - 1, done);
            if (done) break;
        }
#undef AT_BLOCK
#undef AT_LOAD
#pragma unroll
        for (int g = 0; g < 4; ++g) {
            u32x2 w0; w0.x = pk2(O0[4 * g], O0[4 * g + 1]); w0.y = pk2(O0[4 * g + 2], O0[4 * g + 3]);
            u32x2 w1; w1.x = pk2(O1[4 * g], O1[4 * g + 1]); w1.y = pk2(O1[4 * g + 2], O1[4 * g + 3]);
            *(LAS u32x2*)(myl + tl * 144 + (8 * g + 4 * hf) * 2) = w0;
            *(LAS u32x2*)(myl + tl * 144 + (32 + 8 * g + 4 * hf) * 2) = w1;
        }
        asm volatile("s_waitcnt lgkmcnt(0)" ::: "memory");
#pragma unroll
        for (int it = 0; it < 4; ++it) { const int chunk = it * 64 + lane, row = chunk >> 3, c16 = chunk & 7;
            const u32x4 w = *(const LAS u32x4*)(myl + row * 144 + c16 * 16);
            *(u32x4*)(qo + (size_t)(qrow0 + row) * D + h * HD + c16 * 8) = w; }
        asm volatile("s_waitcnt lgkmcnt(0)" ::: "memory");
    }
}

#define XB_TMO      128
#define XB_XCNT(j)  (256  + 64 * (j))
#define XB_XSUB(j)  (1280 + 64 * (j))
#define XB_XGEN(j)  (2304 + 64 * (j))
#define XB_TOP      3328
#define XB_TOPGEN   3392
#define XCD_BAR_WORDS 3456
#define XB_SPIN_CAP (1u << 18)
DI unsigned xb_ld(unsigned* p) { return __hip_atomic_load(p, __ATOMIC_RELAXED, __HIP_MEMORY_SCOPE_AGENT); }
DI unsigned xb_add(unsigned* p, unsigned v) { return __hip_atomic_fetch_add(p, v, __ATOMIC_RELAXED, __HIP_MEMORY_SCOPE_AGENT); }
DI unsigned xb_xcc_id() { return (unsigned)__builtin_amdgcn_s_getreg((3 << 11) | 20) & 0xFu; }
#define XB_SPIN(cond, bar) do { unsigned _sp = 0; while (cond) { __builtin_amdgcn_s_sleep(1); \
    if ((++_sp & 255u) == 0u) { if (xb_ld(&(bar)[XB_TMO])) break; if (_sp > XB_SPIN_CAP) { atomicAdd(&(bar)[XB_TMO], 1u); break; } } } } while (0)
struct XcdBarrier { unsigned* bar; unsigned x; volatile LAS unsigned* st; };
DI XcdBarrier xcd_barrier_post(unsigned* bar, volatile LAS unsigned* st) {
    XcdBarrier b; b.bar = bar; b.x = xb_xcc_id(); b.st = st;
    if (threadIdx.x == 0) (void)xb_add(&bar[XB_XCNT(b.x)], 1u);
    return b;
}
DI void xcd_barrier_complete(unsigned* bar, unsigned x, unsigned& nloc, unsigned& nx) {
    const unsigned Gt = gridDim.x * gridDim.y * gridDim.z;
    unsigned sum, cnt, mine, sp = 0u;
    for (;;) {
        sum = 0u; cnt = 0u; mine = 0u;
#pragma unroll
        for (unsigned j = 0; j < 16; ++j) { const unsigned c = xb_ld(&bar[XB_XCNT(j)]); sum += c; cnt += (c > 0u) ? 1u : 0u; mine = (j == x) ? c : mine; }
        if (sum == Gt) break;
        __builtin_amdgcn_s_sleep(1);
        if ((++sp & 255u) == 0u) { if (xb_ld(&bar[XB_TMO])) break; if (sp > XB_SPIN_CAP) { atomicAdd(&bar[XB_TMO], 1u); break; } }
    }
    nloc = mine > 0u ? mine : 1u; nx = cnt > 0u ? cnt : 1u;
}
DI void xcd_barrier(const XcdBarrier& b) {
    asm volatile("s_waitcnt vmcnt(0)" ::: "memory");
    __syncthreads();
    if (threadIdx.x == 0) {
        unsigned* bar = b.bar;
        __builtin_amdgcn_s_waitcnt(0);
        unsigned nloc = b.st[0], nx = b.st[1];
        if (nloc == 0u) { xcd_barrier_complete(bar, b.x, nloc, nx); b.st[0] = nloc; b.st[1] = nx; }
        const unsigned old = xb_add(&bar[XB_XSUB(b.x)], 1u);
        const unsigned gen = old / nloc;
        if (old + 1u == (gen + 1u) * nloc) {
            __builtin_amdgcn_fence(__ATOMIC_RELEASE, "agent");
            asm volatile("s_waitcnt vmcnt(0)" ::: "memory");
            const unsigned og = xb_add(&bar[XB_TOP], 1u);
            const unsigned tg = og / nx;
            if (og + 1u == (tg + 1u) * nx) xb_add(&bar[XB_TOPGEN], 1u);
            else XB_SPIN(xb_ld(&bar[XB_TOPGEN]) == tg, bar);
            __builtin_amdgcn_fence(__ATOMIC_ACQUIRE, "agent");
            xb_add(&bar[XB_XGEN(b.x)], 1u);
            asm volatile("s_waitcnt vmcnt(0)" ::: "memory");
        } else {
            XB_SPIN(xb_ld(&bar[XB_XGEN(b.x)]) == gen, bar);
            __builtin_amdgcn_fence(__ATOMIC_ACQUIRE, "agent");
            asm volatile("s_waitcnt vmcnt(0)" ::: "memory");
        }
    }
    __syncthreads();
}

__global__ void __launch_bounds__(512, 2) fwd_megakernel(Params p) {
    extern __shared__ __attribute__((aligned(16))) unsigned char smem[];
    LAS unsigned char* lds = (LAS unsigned char*)smem;
    cg::grid_group grid = cg::this_grid();
    const int G = gridDim.x, bx = blockIdx.x, nw = G * 8;
    volatile LAS unsigned* xst = (volatile LAS unsigned*)(lds + 131072);
    if (threadIdx.x == 0) { xst[0] = 0u; xst[1] = 0u; }
    __syncthreads();
    const XcdBarrier gbar = xcd_barrier_post((unsigned*)(p.ws + WS_BAR), xst);
#define LANE_ARGS(t_) (bx * 8 + __builtin_amdgcn_readfirstlane((t_) >> 6)), nw, ((t_) & 63)
    unsigned char* ws = p.ws;
    bf16_t* Win = (bf16_t*)(ws + WS_WIN); bf16_t* Wv = (bf16_t*)(ws + WS_WV); bf16_t* Wa = (bf16_t*)(ws + WS_WA); bf16_t* Wb = (bf16_t*)(ws + WS_WB);
    bf16_t* Wo = (bf16_t*)(ws + WS_WO); bf16_t* Wup = (bf16_t*)(ws + WS_WUP); bf16_t* Wdn = (bf16_t*)(ws + WS_WDN);
    float* mod = (float*)(ws + WS_MOD); bf16_t* ks = (bf16_t*)(ws + WS_KS); bf16_t* vts = (bf16_t*)(ws + WS_VTS);
    bf16_t* slot0 = (bf16_t*)(ws + WS_SLOT0);
    bf16_t* hbuf = (bf16_t*)(ws + WS_BIG);
    bf16_t* kbuf = (bf16_t*)(ws + WS_BIG + U); bf16_t* vT = (bf16_t*)(ws + WS_BIG + 2 * U);
    bf16_t* bg = (bf16_t*)(ws + WS_BIG + 3 * U); bf16_t* cu = (bf16_t*)(ws + WS_BIG + 4 * U);
    bf16_t* act = (bf16_t*)(ws + WS_ACT); bf16_t* hup = (bf16_t*)(ws + WS_HUP); bf16_t* hgt = (bf16_t*)(ws + WS_HGT); bf16_t* tup = (bf16_t*)(ws + WS_TUP); bf16_t* ugs = (bf16_t*)(ws + WS_UGS);
    bf16_t* sga = (bf16_t*)p.out; bf16_t* sgb = (bf16_t*)((unsigned char*)p.out + U);
    float* y = p.out + O_Y;
    bf16_t* xb = (bf16_t*)(ws + WS_BIG + 4 * U);

    phase_prep(p, lds, tid_());
    xcd_barrier(gbar);
    { const int t_ = tid_(); phase_norm_mod(p.x_prompt, p.x_sample, p.g_norm1, mod, 0, hbuf, LANE_ARGS(t_)); }
    xcd_barrier(gbar);
    { const int t_ = tid_(); sample_p2(hbuf, Win, Wv, slot0, ks, vts, bg, cu, sga, sgb, p.out, bx * 8 + __builtin_amdgcn_readfirstlane(t_ >> 6), t_ & 63); }
    { pg8::Gemm g{hbuf, Win, MP, N1, D, D, D}; pg8::StaticOrder S; S.init(MP, N1, G, bx);
      Epi1 E{slot0, kbuf, ks, bg, cu, sga, sgb, p.out}; pg8::gemm_phase<Epi1>(lds, g, S, E); }
    { pg8::Gemm g{Wv, hbuf, D, MP, D, D, D}; pg8::StaticOrder S; S.init(D, MP, G, bx);
      Epi1V E{vT, vts, p.out}; pg8::gemm_phase<Epi1V>(lds, g, S, E); }
    xcd_barrier(gbar);
    { const int t_ = tid_(); phase_attn(slot0, kbuf, vT, ks, vts, lds, __builtin_amdgcn_readfirstlane(t_ >> 6), LANE_ARGS(t_)); }
    { const int t_ = tid_(); phase_ob(p, bg, cu, LANE_ARGS(t_)); }
    xcd_barrier(gbar);
    { const int t_ = tid_(); if (t_ < 64) sample_p4(slot0, bg, Wa, Wb, sga, sgb, hbuf, bx, t_); }
    { pg8::Gemm g{slot0, Wa, MP, D, D, D, D}; pg8::StaticOrder S; S.init(MP, D, G, bx); EpiAB<0> E{sga, hbuf}; pg8::gemm_phase<EpiAB<0>>(lds, g, S, E, STAG_P4); }
    { pg8::Gemm g{bg, Wb, MP, D, D, D, D}; pg8::StaticOrder S; S.init(MP, D, G, bx); EpiAB<1> E{sgb, hbuf}; pg8::gemm_phase<EpiAB<1>>(lds, g, S, E); }
    xcd_barrier(gbar);
    { const int t_ = tid_(); if (t_ < 64) sample_res<0>(hbuf, D, Wo, D, p.x_sample, mod + 2 * D, xb, bx, t_); }
    { pg8::Gemm g{hbuf, Wo, MP, D, D, D, D}; pg8::StaticOrder S; S.init(MP, D, G, bx); EpiRes<0> E{p.x_prompt, mod, xb}; pg8::gemm_phase<EpiRes<0>>(lds, g, S, E, STAG_P5); }
    xcd_barrier(gbar);
    { const int t_ = tid_(); phase_norm_b<0>(xb, p.g_norm2, mod, 3 * D, slot0, nullptr, LANE_ARGS(t_)); }
    xcd_barrier(gbar);
    { const int t_ = tid_(); sample_up(slot0, Wup, ugs, p.out, bx * 8 + __builtin_amdgcn_readfirstlane(t_ >> 6), t_ & 63); }
    { pg8::Gemm g{slot0, Wup, MP, 2 * DFF, D, D, D}; pg8::StaticOrder S; S.init(MP, 2 * DFF, G, bx); EpiUp E{act, hup, hgt, tup, ugs, p.w_fconv, p.b_fconv, p.out}; pg8::gemm_phase<EpiUp>(lds, g, S, E); }
    xcd_barrier(gbar);
    { const int t_ = tid_(); phase_act_fix(p, act, hup, hgt, tup, ugs, LANE_ARGS(t_)); }
    xcd_barrier(gbar);
    { const int t_ = tid_(); if (t_ < 64) sample_res<1>(act, DFF, Wdn, DFF, nullptr, mod + 5 * D, xb, bx, t_); }
    { pg8::Gemm g{act, Wdn, MP, D, DFF, DFF, DFF}; pg8::StaticOrder S; S.init(MP, D, G, bx); EpiRes<1> E{nullptr, mod, xb}; pg8::gemm_phase<EpiRes<1>>(lds, g, S, E, STAG_P9); }
    xcd_barrier(gbar);
    { const int t_ = tid_(); phase_norm_b<1>(xb, p.g_final, nullptr, 0, nullptr, y, LANE_ARGS(t_)); }
    if (p.out == nullptr) grid.sync();
}

extern "C" void kernel_launch(void* const* d_in, const int* in_sizes, int n_in, void* d_out, int out_size, void* d_ws, size_t ws_size, hipStream_t stream) {
    static int grid_blocks = 0;
    if (grid_blocks == 0) {
        if (n_in != 23 || (size_t)out_size != O_END || ws_size < WS_BAR + XCD_BAR_WORDS * 4) { fprintf(stderr, "kernel_launch: unexpected shapes: n_in %d out %d ws %zu (need %zu)\n", n_in, out_size, ws_size, (size_t)WS_END); grid_blocks = -1; return; }
        int dev = 0, cus = 0, per_cu = 0;
        hipGetDevice(&dev);
        hipDeviceGetAttribute(&cus, hipDeviceAttributeMultiprocessorCount, dev);
        if (hipFuncSetAttribute((const void*)fwd_megakernel, hipFuncAttributeMaxDynamicSharedMemorySize, LDS_BYTES) != hipSuccess) { fprintf(stderr, "kernel_launch: hipFuncSetAttribute failed\n"); grid_blocks = -1; return; }
        hipOccupancyMaxActiveBlocksPerMultiprocessor(&per_cu, (const void*)fwd_megakernel, 512, LDS_BYTES);
        if (per_cu < 1) { fprintf(stderr, "kernel_launch: occupancy query says 0 blocks per CU\n"); per_cu = 1; }
        grid_blocks = cus * 1;
        (void)hipGetLastError();
    }
    if (grid_blocks < 0) return;
    if (hipMemsetAsync((char*)d_ws + WS_BAR, 0, XCD_BAR_WORDS * 4, stream) != hipSuccess) { fprintf(stderr, "kernel_launch: hipMemsetAsync of the barrier counter failed\n"); return; }
    Params p{};
    const float** pp = (const float**)&p;
    for (int i = 0; i < 23; ++i) pp[i] = (const float*)d_in[i];
    p.out = (float*)d_out; p.ws = (unsigned char*)d_ws;
    void* args[] = {&p};
    hipError_t e = hipLaunchCooperativeKernel((const void*)fwd_megakernel, dim3(grid_blocks), dim3(512), args, LDS_BYTES, stream);
    if (e != hipSuccess) fprintf(stderr, "cooperative launch failed: %s (grid %d)\n", hipGetErrorString(e), grid_blocks);
}
```

```cpp
#include <hip/hip_runtime.h>
#include <hip/hip_cooperative_groups.h>
#include <cstdio>
namespace cg = cooperative_groups;

#define LAS __attribute__((address_space(3)))
#define DI __device__ __forceinline__
typedef unsigned short bf16_t;
typedef short bf16x8 __attribute__((ext_vector_type(8)));
typedef short s16x4 __attribute__((ext_vector_type(4)));
typedef float f32x2 __attribute__((ext_vector_type(2)));
typedef float f32x4 __attribute__((ext_vector_type(4)));
typedef float f32x16 __attribute__((ext_vector_type(16)));
typedef unsigned u32x2 __attribute__((ext_vector_type(2)));
typedef unsigned u32x4 __attribute__((ext_vector_type(4)));
typedef __bf16 bf2_t __attribute__((ext_vector_type(2)));

constexpr int D = 1024, NB = 16, T = 4096, MP = NB * T, SB = 8, ST = 32, MS = SB * ST, M = MP + MS;
constexpr int PAST = 1024, SKV = PAST + ST, DFF = 2816, NH = 16, HD = 64, NMOD = 6 * D;
constexpr int N1 = 7168;
constexpr size_t O_Y = 0, O_KP = 67371008, O_VP = 134479872, O_CP = 201588736, O_FP = 201621504, O_KS = 201711616,
                 O_VS = 201973760, O_CS = 202235904, O_FS = 202252288, O_END = 202297344;
constexpr size_t U = (size_t)M * D * 2;
constexpr size_t WS_WIN = 0, WS_WV = WS_WIN + (size_t)N1 * D * 2, WS_WA = WS_WV + (size_t)D * D * 2, WS_WB = WS_WA + (size_t)D * D * 2,
                 WS_WO = WS_WB + (size_t)D * D * 2, WS_WUP = WS_WO + (size_t)D * D * 2, WS_WDN = WS_WUP + (size_t)2 * DFF * D * 2,
                 WS_MOD = WS_WDN + (size_t)D * DFF * 2, WS_KS = WS_MOD + (size_t)24 * NMOD * 4, WS_VTS = WS_KS + (size_t)SB * SKV * D * 2,
                 WS_SLOT0 = WS_VTS + (size_t)SB * D * SKV * 2, WS_BIG = WS_SLOT0 + U,
                 WS_ACT = WS_BIG,
                 WS_HUP = WS_ACT + (size_t)M * DFF * 2, WS_HGT = WS_HUP + (size_t)(MP / 64) * 2 * DFF * 2, WS_TUP = WS_HGT + (size_t)(MP / 64) * 2 * DFF * 2,
                 WS_UGS = WS_TUP + (size_t)(MP / 64) * 2 * DFF * 2, WS_ACT_END = WS_UGS + (size_t)MS * 2 * DFF * 2,
                 WS_END = (WS_BIG + 5 * U > WS_ACT_END) ? WS_BIG + 5 * U : WS_ACT_END;
constexpr int LDS_BYTES = 131072 + 64;
constexpr size_t WS_BAR = WS_END + 4096;
constexpr float QSCALE = 0.125f * 1.4426950408889634f;
#ifndef STAG_P4
#define STAG_P4 0
#define STAG_P5 0
#define STAG_P9 0
#endif

DI unsigned pk2(float lo, float hi) { f32x2 v = {lo, hi}; return __builtin_bit_cast(unsigned, __builtin_convertvector(v, bf2_t)); }
DI float bflo(unsigned w) { return __uint_as_float(w << 16); }
DI float bfhi(unsigned w) { return __uint_as_float(w & 0xffff0000u); }
DI u32x4 pk8(f32x4 a, f32x4 b) { u32x4 w; w.x = pk2(a[0], a[1]); w.y = pk2(a[2], a[3]); w.z = pk2(b[0], b[1]); w.w = pk2(b[2], b[3]); return w; }
DI float sigmoidf_(float x) { return __builtin_amdgcn_rcpf(1.0f + __expf(-x)); }
DI int tid_() { int t = threadIdx.x; asm volatile("" : "+v"(t)); return t; }
DI int bidx_of(int row) { return row < MP ? (row >> 12) : 16 + ((row - MP) >> 5); }

namespace pg8 {
constexpr int BM = 256, BK = 64, HALF = 128, HTB = HALF * BK * 2, STAGE_BYTES = 8 * HTB, NXCD = 8, WGM = 8;
DI int lds_byte(int r, int c) { const int st = (r >> 4) * 2 + (c >> 5), rr = r & 15, cc = c & 31, ob = rr * 64 + cc * 2; return st * 1024 + (ob ^ (((ob >> 9) & 1) << 5)); }
DI void stage_rc(int b, int& R, int& C) { const int st = b / 1024, sb = b % 1024, swz = sb ^ (((sb >> 9) & 1) << 5); R = (st >> 1) * 16 + swz / 64; C = (st & 1) * 32 + (swz % 64) / 2; }
DI int perm32(int rho) { const int n = rho >> 4, i = rho & 15; return 8 * (i >> 2) + 4 * n + (i & 3); }
struct Unit { int pm, pn; };
struct Gemm { const bf16_t* A; const bf16_t* Bt; int M, N, K, lda, ldb; };
struct StaticOrder {
    int nM, nN, nwg, G, c;
    DI void init(int M_, int N_, int G_, int c_) { nM = M_ / BM; nN = N_ / BM; nwg = nM * nN; G = G_; c = c_; }
    DI bool next(int i, Unit& u) const {
        const long L = (long)i * G + c; if (L >= nwg) return false;
        int wgid = (int)L; { const int q = nwg / NXCD, r = nwg % NXCD, xcd = wgid % NXCD, off = wgid / NXCD; wgid = (xcd < r ? xcd * (q + 1) : r * (q + 1) + (xcd - r) * q) + off; }
        const int nig = WGM * nN, gid = wgid / nig, fm = gid * WGM, gsz = (nM - fm) < WGM ? (nM - fm) : WGM;
        u.pm = fm + ((wgid % nig) % gsz); u.pn = (wgid % nig) / gsz; return true;
    }
};

template <class Epi>
DI void gemm_phase(LAS unsigned char* lds, const Gemm g, const StaticOrder& S, const Epi& E, int stag = 0) {
    const int tid = tid_(), wid = __builtin_amdgcn_readfirstlane(tid >> 6), lane = tid & 63, wr = wid >> 2, wc = wid & 3, fr = lane & 15, fq = lane >> 4;
    const int K = g.K, nt = K / BK;
    unsigned voffA[2], voffB[2];
#pragma unroll
    for (int i = 0; i < 2; ++i) { int R, C; stage_rc(tid * 16 + i * 8192, R, C); const int Rb = Epi::PERM ? ((R & ~31) + perm32(R & 31)) : R;
        voffA[i] = (unsigned)(R * g.lda + C) * 2u; voffB[i] = (unsigned)(Rb * g.ldb + C) * 2u; }
    const size_t kstep = (size_t)(BK * 2);
    const size_t hstepA = (size_t)HALF * g.lda * 2, hstepB = (size_t)HALF * g.ldb * 2;
    const size_t tstepA = 2 * hstepA, tstepB = 2 * hstepB;
    const unsigned ldsw = (unsigned)wid * 1024u;
    const int aoff = lds_byte(wr * 64 + fr, fq * 8), boff = lds_byte(wc * 32 + fr, fq * 8);
#define PG8_SA(b, h) (((b) * 2 + (h)) * HTB)
#define PG8_SB(b, h) ((4 + (b) * 2 + (h)) * HTB)
#define PG8_STAGE(bufoff, gbase, voff) do { _Pragma("unroll") for (int _i = 0; _i < 2; ++_i) \
        __builtin_amdgcn_global_load_lds((const unsigned*)((const char*)(gbase) + (voff)[_i]), (LAS unsigned*)(lds + (bufoff) + ldsw + _i * 8192), 16, 0, 0); } while (0)
#define PG8_LDA(dst, b, h) do { _Pragma("unroll") for (int m = 0; m < 4; ++m) _Pragma("unroll") for (int k = 0; k < 2; ++k) dst[m][k] = *(const LAS bf16x8*)(lds + PG8_SA(b, h) + aoff + m * 2048 + k * 1024); } while (0)
#define PG8_LDB(dst, b, h) do { _Pragma("unroll") for (int n = 0; n < 2; ++n) _Pragma("unroll") for (int k = 0; k < 2; ++k) dst[n][k] = *(const LAS bf16x8*)(lds + PG8_SB(b, h) + boff + n * 2048 + k * 1024); } while (0)
#define PG8_MMA(ai, bj, At, Bt) do { __builtin_amdgcn_s_setprio(1); _Pragma("unroll") for (int m = 0; m < 4; ++m) _Pragma("unroll") for (int n = 0; n < 2; ++n) _Pragma("unroll") for (int k = 0; k < 2; ++k) \
        acc[ai][bj][m][n] = __builtin_amdgcn_mfma_f32_16x16x32_bf16(Bt[n][k], At[m][k], acc[ai][bj][m][n], 0, 0, 0); __builtin_amdgcn_s_setprio(0); } while (0)
#define PG8_WAIT_V(n) asm volatile("s_waitcnt vmcnt(" #n ")" ::: "memory")
#define PG8_WAIT_L(n) asm volatile("s_waitcnt lgkmcnt(" #n ")" ::: "memory")
#define PG8_BAR __builtin_amdgcn_s_barrier()
#define PG8_SCHED __builtin_amdgcn_sched_barrier(0)
    Unit cur, nxt; int ui = 0;
    if (!S.next(0, cur)) return;
    if (stag) {
        const int slot = (blockIdx.x >> 3) & 15;
        if (slot) { const unsigned long long t0 = __builtin_amdgcn_s_memrealtime(), dl = (unsigned long long)(slot * stag) >> 4;
            while (__builtin_amdgcn_s_memrealtime() - t0 < dl) __builtin_amdgcn_s_sleep(8); }
    }
    f32x4 acc[2][2][4][2];
#pragma unroll
    for (int a = 0; a < 2; ++a)
#pragma unroll
        for (int b = 0; b < 2; ++b)
#pragma unroll
            for (int m = 0; m < 4; ++m)
#pragma unroll
                for (int n = 0; n < 2; ++n) acc[a][b][m][n] = (f32x4){0.f, 0.f, 0.f, 0.f};
    bf16x8 At[4][2], B0[2][2], B1[2][2];
    const char* cA = (const char*)g.A + (size_t)cur.pm * tstepA; const char* cB = (const char*)g.Bt + (size_t)cur.pn * tstepB;
    PG8_STAGE(PG8_SB(0, 0), cB, voffB); PG8_STAGE(PG8_SA(0, 0), cA, voffA); PG8_STAGE(PG8_SB(0, 1), cB + hstepB, voffB); PG8_STAGE(PG8_SA(0, 1), cA + hstepA, voffA);
    if (wr == 1) PG8_BAR;
    PG8_WAIT_V(4); PG8_BAR;
    PG8_STAGE(PG8_SB(1, 0), cB + kstep, voffB); PG8_STAGE(PG8_SA(1, 0), cA + kstep, voffA); PG8_STAGE(PG8_SB(1, 1), cB + hstepB + kstep, voffB);
    PG8_WAIT_V(6); PG8_BAR;
    for (;;) {
        const bool has_next = S.next(ui + 1, nxt);
        const char* nA = has_next ? (const char*)g.A + (size_t)nxt.pm * tstepA : cA; const char* nB = has_next ? (const char*)g.Bt + (size_t)nxt.pn * tstepB : cB;
        for (int t = 0; t < nt; t += 2) {
            const bool last = (t == nt - 2);
            const char* a1 = cA + (size_t)(t + 1) * kstep;
            const char* a2 = last ? nA : cA + (size_t)(t + 2) * kstep; const char* b2 = last ? nB : cB + (size_t)(t + 2) * kstep;
            const char* a3 = a2 + kstep; const char* b3 = b2 + kstep;
            PG8_LDB(B0, 0, 0); PG8_SCHED; PG8_LDA(At, 0, 0); PG8_STAGE(PG8_SA(1, 1), a1 + hstepA, voffA);
            PG8_WAIT_L(8); PG8_BAR; PG8_WAIT_L(0); PG8_MMA(0, 0, At, B0); PG8_BAR; PG8_SCHED;
            PG8_LDB(B1, 0, 1); PG8_STAGE(PG8_SB(0, 0), b2, voffB);
            PG8_BAR; PG8_WAIT_L(0); PG8_MMA(0, 1, At, B1); PG8_BAR;
            PG8_LDA(At, 0, 1); PG8_STAGE(PG8_SA(0, 0), a2, voffA);
            PG8_BAR; PG8_WAIT_L(0); PG8_MMA(1, 0, At, B0); PG8_BAR; PG8_SCHED;
            PG8_STAGE(PG8_SB(0, 1), b2 + hstepB, voffB);
            PG8_WAIT_V(6); PG8_BAR; PG8_MMA(1, 1, At, B1); PG8_BAR;
            PG8_LDB(B0, 1, 0); PG8_SCHED; PG8_LDA(At, 1, 0); PG8_STAGE(PG8_SA(0, 1), a2 + hstepA, voffA);
            PG8_WAIT_L(8); PG8_BAR; PG8_WAIT_L(0); PG8_MMA(0, 0, At, B0); PG8_BAR; PG8_SCHED;
            PG8_LDB(B1, 1, 1); PG8_STAGE(PG8_SB(1, 0), b3, voffB);
            PG8_BAR; PG8_WAIT_L(0); PG8_MMA(0, 1, At, B1); PG8_BAR;
            PG8_LDA(At, 1, 1); PG8_STAGE(PG8_SA(1, 0), a3, voffA);
            PG8_BAR; PG8_WAIT_L(0); PG8_MMA(1, 0, At, B0); PG8_BAR; PG8_SCHED;
            PG8_STAGE(PG8_SB(1, 1), b3 + hstepB, voffB);
            PG8_WAIT_V(6); PG8_BAR; PG8_MMA(1, 1, At, B1); PG8_BAR;
        }
        E(acc, cur, wr, wc, fr, fq);
        if (!has_next) break;
#pragma unroll
        for (int a = 0; a < 2; ++a)
#pragma unroll
            for (int b = 0; b < 2; ++b)
#pragma unroll
                for (int m = 0; m < 4; ++m)
#pragma unroll
                    for (int n = 0; n < 2; ++n) acc[a][b][m][n] = (f32x4){0.f, 0.f, 0.f, 0.f};
        cur = nxt; cA = nA; cB = nB; ++ui;
    }
    PG8_WAIT_V(0);
    if (wr == 0) PG8_BAR;
    PG8_BAR;
#undef PG8_SA
#undef PG8_SB
#undef PG8_STAGE
#undef PG8_LDA
#undef PG8_LDB
#undef PG8_MMA
#undef PG8_WAIT_V
#undef PG8_WAIT_L
#undef PG8_BAR
#undef PG8_SCHED
}
}
using pg8::Unit;
typedef const f32x4 (&AccRef)[2][2][4][2];

struct Epi1 {
    static constexpr bool PERM = true;
    bf16_t *q, *kbuf, *ks, *bg, *cu, *sga, *sgb; float* out;
    DI void operator()(AccRef acc, const Unit& u, int wr, int wc, int fr, int fq) const {
        asm volatile("" : "+v"(fr), "+v"(fq));
        const int pn = u.pn, rbase = u.pm * 256 + wr * 64 + fr, cl = wc * 32 + 8 * fq;
        if (pn >= 12 && pn < 20) {
            const int ch = (pn - 12) * 128 + cl;
#pragma unroll
            for (int ai = 0; ai < 2; ++ai)
#pragma unroll
                for (int m = 0; m < 4; ++m) {
                    const int row = rbase + ai * 128 + m * 16;
                    const f32x4 p0 = acc[ai][0][m][0] * acc[ai][1][m][0], p1 = acc[ai][0][m][1] * acc[ai][1][m][1];
                    *(u32x4*)(cu + (size_t)row * D + ch) = pk8(p0, p1);
                    float* dst = nullptr;
                    if (row < MP) { const int t = row & (T - 1); if (t >= T - 2) dst = out + O_CP + ((size_t)(row >> 12) * 2 + (t - (T - 2))) * D + ch; }
                    else { const int rs = row - MP, i = rs & 31; if (i >= ST - 2) dst = out + O_CS + ((size_t)(rs >> 5) * 2 + (i - (ST - 2))) * D + ch; }
                    if (dst) { *(f32x4*)dst = p0; *(f32x4*)(dst + 4) = p1; }
                }
            return;
        }
#pragma unroll
        for (int ai = 0; ai < 2; ++ai)
#pragma unroll
            for (int m = 0; m < 4; ++m) {
                const int row = rbase + ai * 128 + m * 16;
#pragma unroll
                for (int bj = 0; bj < 2; ++bj) {
                    f32x4 v0 = acc[ai][bj][m][0], v1 = acc[ai][bj][m][1];
                    if (pn < 4) { const int col = pn * 256 + bj * 128 + cl; *(u32x4*)(q + (size_t)row * D + col) = pk8(v0 * QSCALE, v1 * QSCALE); }
                    else if (pn < 8) {
                        const int col = (pn - 4) * 256 + bj * 128 + cl;
                        bf16_t* kd; float* od;
                        const int hh = col >> 6, dd = col & 63;
                        if (row < MP) { kd = kbuf + (((size_t)(row >> 12) * NH + hh) * T + (row & (T - 1))) * HD + dd; od = out + O_KP + (size_t)row * D + col; }
                        else { const int rs = row - MP; kd = ks + (((size_t)(rs >> 5) * NH + hh) * SKV + PAST + (rs & 31)) * HD + dd; od = out + O_KS + (size_t)rs * D + col; }
                        *(u32x4*)kd = pk8(v0, v1); *(f32x4*)od = v0; *(f32x4*)(od + 4) = v1;
                    }
                    else if (pn < 12) { const int col = (pn - 8) * 256 + bj * 128 + cl; *(u32x4*)(bg + (size_t)row * D + col) = pk8(v0, v1); }
                    else {
                        bf16_t* dst = (pn < 24) ? sga : sgb; const int col = ((pn - 20) & 3) * 256 + bj * 128 + cl;
#pragma unroll
                        for (int j = 0; j < 4; ++j) { v0[j] = sigmoidf_(v0[j]); v1[j] = sigmoidf_(v1[j]); }
                        *(u32x4*)(dst + (size_t)row * D + col) = pk8(v0, v1);
                    }
                }
            }
    }
};
struct Epi1V {
    static constexpr bool PERM = true;
    bf16_t *vT, *vts; float* out;
    DI void operator()(AccRef acc, const Unit& u, int wr, int wc, int fr, int fq) const {
        asm volatile("" : "+v"(fr), "+v"(fq));
        const int rbase = u.pm * 256 + wr * 64 + fr, cl = wc * 32 + 8 * fq;
#pragma unroll
        for (int ai = 0; ai < 2; ++ai)
#pragma unroll
            for (int m = 0; m < 4; ++m) {
                const int r = rbase + ai * 128 + m * 16;
#pragma unroll
                for (int bj = 0; bj < 2; ++bj) {
                    const int tok = u.pn * 256 + bj * 128 + cl;
                    const f32x4 v0 = acc[ai][bj][m][0], v1 = acc[ai][bj][m][1];
                    float* od;
                    const int hh = r >> 6, dd = r & 63; bf16_t* vd;
                    if (tok < MP) { const int t = tok & (T - 1); vd = vT + (((size_t)(tok >> 12) * NH + hh) * (T / 32) + (t >> 5)) * 2048 + dd * 32 + ((t & 31) >> 3) * 4; od = out + O_VP + (size_t)tok * D + r; }
                    else { const int ts = tok - MP; vd = vts + (((size_t)(ts >> 5) * NH + hh) * (SKV / 32) + PAST / 32) * 2048 + dd * 32 + ((ts & 31) >> 3) * 4; od = out + O_VS + (size_t)ts * D + r; }
                    { u32x2 w0, w1; w0.x = pk2(v0[0], v0[1]); w0.y = pk2(v0[2], v0[3]); w1.x = pk2(v1[0], v1[1]); w1.y = pk2(v1[2], v1[3]); *(u32x2*)vd = w0; *(u32x2*)(vd + 16) = w1; }
#pragma unroll
                    for (int j = 0; j < 4; ++j) { od[(size_t)j * D] = v0[j]; od[(size_t)(j + 4) * D] = v1[j]; }
                }
            }
    }
};
template <int MODE  > struct EpiAB {
    static constexpr bool PERM = true;
    const bf16_t* sg; bf16_t* tm;
    DI void operator()(AccRef acc, const Unit& u, int wr, int wc, int fr, int fq) const {
        asm volatile("" : "+v"(fr), "+v"(fq));
        const int rbase = u.pm * 256 + wr * 64 + fr, cb = u.pn * 256 + wc * 32 + 8 * fq;
#pragma unroll
        for (int ai = 0; ai < 2; ++ai) {
            u32x4 sv[4][2], pv[4][2];
#pragma unroll
            for (int m = 0; m < 4; ++m)
#pragma unroll
                for (int bj = 0; bj < 2; ++bj) { const size_t o = (size_t)(rbase + ai * 128 + m * 16) * D + cb + bj * 128;
                    sv[m][bj] = *(const u32x4*)(sg + o); if (MODE == 1) pv[m][bj] = *(const u32x4*)(tm + o); }
#pragma unroll
            for (int m = 0; m < 4; ++m)
#pragma unroll
                for (int bj = 0; bj < 2; ++bj) { const size_t o = (size_t)(rbase + ai * 128 + m * 16) * D + cb + bj * 128;
                    const u32x4 s = sv[m][bj];
                    f32x4 v0 = acc[ai][bj][m][0], v1 = acc[ai][bj][m][1];
                    v0[0] *= bflo(s.x); v0[1] *= bfhi(s.x); v0[2] *= bflo(s.y); v0[3] *= bfhi(s.y);
                    v1[0] *= bflo(s.z); v1[1] *= bfhi(s.z); v1[2] *= bflo(s.w); v1[3] *= bfhi(s.w);
                    if (MODE == 1) { const u32x4 p = pv[m][bj];
                        v0[0] += bflo(p.x); v0[1] += bfhi(p.x); v0[2] += bflo(p.y); v0[3] += bfhi(p.y);
                        v1[0] += bflo(p.z); v1[1] += bfhi(p.z); v1[2] += bflo(p.w); v1[3] += bfhi(p.w); }
                    *(u32x4*)(tm + o) = pk8(v0, v1); }
        }
    }
};
template <int MODE  > struct EpiRes {
    static constexpr bool PERM = true;
    const float *xp, *mod; bf16_t* xb;
    DI void operator()(AccRef acc, const Unit& u, int wr, int wc, int fr, int fq) const {
        asm volatile("" : "+v"(fr), "+v"(fq));
        const int rbase = u.pm * 256 + wr * 64 + fr, cb = u.pn * 256 + wc * 32 + 8 * fq;
        const float* gp = mod + (size_t)(u.pm >> 4) * NMOD + (MODE == 0 ? 2 * D : 5 * D) + cb;
        f32x4 gv[2][2];
#pragma unroll
        for (int bj = 0; bj < 2; ++bj)
#pragma unroll
            for (int n = 0; n < 2; ++n) gv[bj][n] = *(const f32x4*)(gp + bj * 128 + n * 4);
#pragma unroll
        for (int ai = 0; ai < 2; ++ai)
#pragma unroll
            for (int mp = 0; mp < 4; mp += 2) {
                f32x4 xv[2][2][2];
#pragma unroll
                for (int mm = 0; mm < 2; ++mm)
#pragma unroll
                    for (int bj = 0; bj < 2; ++bj) { const size_t o = (size_t)(rbase + ai * 128 + (mp + mm) * 16) * D + cb + bj * 128;
                        if (MODE == 0) { xv[mm][bj][0] = *(const f32x4*)(xp + o); xv[mm][bj][1] = *(const f32x4*)(xp + o + 4); }
                        else { const u32x4 w = *(const u32x4*)(xb + o); xv[mm][bj][0] = (f32x4){bflo(w.x), bfhi(w.x), bflo(w.y), bfhi(w.y)}; xv[mm][bj][1] = (f32x4){bflo(w.z), bfhi(w.z), bflo(w.w), bfhi(w.w)}; } }
#pragma unroll
                for (int mm = 0; mm < 2; ++mm)
#pragma unroll
                    for (int bj = 0; bj < 2; ++bj) { const size_t o = (size_t)(rbase + ai * 128 + (mp + mm) * 16) * D + cb + bj * 128;
                        *(u32x4*)(xb + o) = pk8(xv[mm][bj][0] + gv[bj][0] * acc[ai][bj][mp + mm][0], xv[mm][bj][1] + gv[bj][1] * acc[ai][bj][mp + mm][1]); }
            }
    }
};
DI void unpack8(const u32x4 w, float (&f)[8]) { f[0] = bflo(w.x); f[1] = bfhi(w.x); f[2] = bflo(w.y); f[3] = bfhi(w.y); f[4] = bflo(w.z); f[5] = bfhi(w.z); f[6] = bflo(w.w); f[7] = bfhi(w.w); }
DI u32x4 shfl4(const u32x4 w, int src) { u32x4 r; r.x = __shfl((int)w.x, src); r.y = __shfl((int)w.y, src); r.z = __shfl((int)w.z, src); r.w = __shfl((int)w.w, src); return r; }
struct EpiUp {
    static constexpr bool PERM = true;
    bf16_t *act, *hup, *hgt, *tup, *ugs; const float *wf, *bfc; float* out;
    DI void operator()(AccRef acc, const Unit& u, int wr, int wc, int fr, int fq) const {
        asm volatile("" : "+v"(fr), "+v"(fq));
        const int ch = u.pn * 128 + wc * 32 + 8 * fq;
        if (u.pm >= MP / 256) {
#pragma unroll
            for (int ai = 0; ai < 2; ++ai)
#pragma unroll
                for (int m = 0; m < 4; ++m) { const int rs = ai * 128 + wr * 64 + m * 16 + fr, i = rs & 31;
                    *(u32x4*)(ugs + (size_t)rs * (2 * DFF) + ch) = pk8(acc[ai][0][m][0], acc[ai][0][m][1]);
                    *(u32x4*)(ugs + (size_t)rs * (2 * DFF) + DFF + ch) = pk8(acc[ai][1][m][0], acc[ai][1][m][1]);
                    if (i >= ST - 2) { float* dst = out + O_FS + ((size_t)(rs >> 5) * 2 + (i - (ST - 2))) * DFF + ch; *(f32x4*)dst = acc[ai][0][m][0]; *(f32x4*)(dst + 4) = acc[ai][0][m][1]; } }
            return;
        }
        const int src1 = fq * 16 + ((fr - 1) & 15), src2 = fq * 16 + ((fr - 2) & 15);
        u32x2 ysave[2][4];
#pragma unroll
        for (int n = 0; n < 2; ++n) {
            const int ch4 = ch + 4 * n;
            const f32x4 w0 = *(const f32x4*)(wf + ch4), w1 = *(const f32x4*)(wf + DFF + ch4), w2 = *(const f32x4*)(wf + 2 * DFF + ch4), bb = *(const f32x4*)(bfc + ch4);
#pragma unroll
            for (int ai = 0; ai < 2; ++ai) {
                const int strip = u.pm * 4 + ai * 2 + wr, row0 = u.pm * 256 + ai * 128 + wr * 64 + fr;
                u32x2 r1p = {0u, 0u}, r2p = {0u, 0u};
#pragma unroll
                for (int m = 0; m < 4; ++m) {
                    const f32x4 ua = acc[ai][0][m][n], ga = acc[ai][1][m][n];
                    u32x2 upk; upk.x = pk2(ua[0], ua[1]); upk.y = pk2(ua[2], ua[3]);
                    u32x2 r1, r2; r1.x = __shfl((int)upk.x, src1); r1.y = __shfl((int)upk.y, src1); r2.x = __shfl((int)upk.x, src2); r2.y = __shfl((int)upk.y, src2);
                    u32x2 q1, q2; q1.x = fr == 0 ? r1p.x : r1.x; q1.y = fr == 0 ? r1p.y : r1.y; q2.x = fr < 2 ? r2p.x : r2.x; q2.y = fr < 2 ? r2p.y : r2.y;
                    r1p = r1; r2p = r2;
                    const f32x4 p1 = {bflo(q1.x), bfhi(q1.x), bflo(q1.y), bfhi(q1.y)}, p2 = {bflo(q2.x), bfhi(q2.x), bflo(q2.y), bfhi(q2.y)};
                    const f32x4 uc = w0 * p2 + w1 * p1 + w2 * ua + bb;
                    f32x4 yv;
#pragma unroll
                    for (int j = 0; j < 4; ++j) yv[j] = ga[j] * uc[j] * __builtin_amdgcn_rcpf(1.0f + __expf(-uc[j]));
                    u32x2 ypk; ypk.x = pk2(yv[0], yv[1]); ypk.y = pk2(yv[2], yv[3]);
                    const int row = row0 + m * 16;
                    if (m == 0 && fr < 2) {
                        u32x2 gpk; gpk.x = pk2(ga[0], ga[1]); gpk.y = pk2(ga[2], ga[3]);
                        *(u32x2*)(hup + ((size_t)strip * 2 + fr) * DFF + ch4) = upk;
                        *(u32x2*)(hgt + ((size_t)strip * 2 + fr) * DFF + ch4) = gpk;
                    } else if (n == 0) ysave[ai][m] = ypk;
                    else { u32x4 w; w.x = ysave[ai][m].x; w.y = ysave[ai][m].y; w.z = ypk.x; w.w = ypk.y; *(u32x4*)(act + (size_t)row * DFF + ch) = w; }
                    if (m == 3 && fr >= 14) {
                        *(u32x2*)(tup + ((size_t)strip * 2 + (fr - 14)) * DFF + ch4) = upk;
                        const int t = row & (T - 1);
                        if (t >= T - 2) *(f32x4*)(out + O_FP + ((size_t)(row >> 12) * 2 + (t - (T - 2))) * DFF + ch4) = ua;
                    }
                }
            }
        }
    }
};

DI int win_srccol(int n) {
    if (n < 2048) return n;
    if (n < 3072) return n + 1024;
    if (n < 5120) { const int j = (n - 3072) >> 8, r = (n - 3072) & 255; return r < 128 ? 4096 + 128 * j + r : 5120 + 128 * j + (r - 128); }
    return n + 1024;
}

DI int wup_srccol(int n) { const int j = n >> 8, r = n & 255; return r < 128 ? 128 * j + r : DFF + 128 * j + (r - 128); }

struct Params {
    const float *x_prompt, *x_sample, *cache_k, *cache_v, *state_conv, *state_ffn, *c_prompt, *c_sample, *w_ada, *b_ada, *g_norm1, *w_in, *w_conv, *b_conv,
                *w_branch_a, *w_branch_b, *w_out, *g_norm2, *w_up, *w_fconv, *b_fconv, *w_down, *g_final;
    float* out; unsigned char* ws;
};

DI void phase_prep(const Params& p, LAS unsigned char* lds, int tid) {
    LAS float* sm = (LAS float*)lds;
    unsigned char* ws = p.ws;
    const int G = gridDim.x, bx = blockIdx.x;
    constexpr int T_WIN = (N1 / 64) * 16, T_WV = 256, T_SQ = 256, T_WUP = (2 * DFF / 64) * 16, T_WDN = 16 * (DFF / 64), T_CV = SB * 256;
    constexpr int E1 = T_WIN, E2 = E1 + T_WV, E3 = E2 + T_SQ, E4 = E3 + T_SQ, E5 = E4 + T_SQ, E6 = E5 + T_WUP, E7 = E6 + T_WDN, E8 = E7 + T_CV;
    constexpr int S_WIN = (N1 / 64) * 4, S_WV = 64, S_SQ = 64, S_WUP = (2 * DFF / 64) * 4, S_WDN = 16 * (DFF / 256), S_CV = SB * 64;
    constexpr int F1 = S_WIN, F2 = F1 + S_WV, F3 = F2 + S_SQ, F4 = F3 + S_SQ, F5 = F4 + S_SQ, F6 = F5 + S_WUP, F7 = F6 + S_WDN, F8 = F7 + S_CV;
#define TILE_DESC(t, src, lds_, dst, ldd) do { \
        if (t < F1) { const int nt = t >> 2, kt = t & 3; src = p.w_in + (size_t)kt * 256 * 8192 + win_srccol(nt * 64); lds_ = 8192; dst = (bf16_t*)(ws + WS_WIN) + (size_t)nt * 64 * D + kt * 256; ldd = D; } \
        else if (t < F2) { const int q = t - F1, nt = q >> 2, kt = q & 3; src = p.w_in + (size_t)kt * 256 * 8192 + 2048 + nt * 64; lds_ = 8192; dst = (bf16_t*)(ws + WS_WV) + (size_t)nt * 64 * D + kt * 256; ldd = D; } \
        else if (t < F5) { const int w = (t - F2) >> 6, q = (t - F2) & 63, nt = q >> 2, kt = q & 3; \
            const float* sb = w == 0 ? p.w_branch_a : (w == 1 ? p.w_branch_b : p.w_out); const size_t off = w == 0 ? WS_WA : (w == 1 ? WS_WB : WS_WO); \
            src = sb + (size_t)kt * 256 * D + nt * 64; lds_ = D; dst = (bf16_t*)(ws + off) + (size_t)nt * 64 * D + kt * 256; ldd = D; } \
        else if (t < F6) { const int q = t - F5, nt = q >> 2, kt = q & 3; src = p.w_up + (size_t)kt * 256 * (2 * DFF) + wup_srccol(nt * 64); lds_ = 2 * DFF; dst = (bf16_t*)(ws + WS_WUP) + (size_t)nt * 64 * D + kt * 256; ldd = D; } \
        else if (t < F7) { const int q = t - F6, nt = q / (DFF / 256), kt = q % (DFF / 256); src = p.w_down + (size_t)kt * 256 * D + nt * 64; lds_ = D; dst = (bf16_t*)(ws + WS_WDN) + (size_t)nt * 64 * DFF + kt * 256; ldd = DFF; } \
        else { const int q = t - F7, b = q >> 6, nt = (q >> 2) & 15, kt = q & 3; \
            src = p.cache_v + (size_t)b * PAST * D + (size_t)kt * 256 * D + nt * 64; lds_ = D; dst = (bf16_t*)(ws + WS_VTS) + (((size_t)b * NH + nt) * (SKV / 32) + kt * 8) * 2048; ldd = -1; } } while (0)
    {
        const int c4 = tid & 15, kk0 = tid >> 4;
        const float* src; int lds_; bf16_t* dst; int ldd;
        f32x4 rv[8];
        if (bx < F8) { TILE_DESC(bx, src, lds_, dst, ldd);
#pragma unroll
            for (int i = 0; i < 8; ++i) rv[i] = *(const f32x4*)(src + (size_t)(kk0 + 32 * i) * lds_ + c4 * 4); }
        for (int t = bx; t < F8; t += G) {
#pragma unroll
            for (int i = 0; i < 8; ++i)
#pragma unroll
                for (int j = 0; j < 4; ++j) sm[(c4 * 4 + j) * 257 + kk0 + 32 * i] = rv[i][j];
            __syncthreads();
            bf16_t* cdst = dst; const int cldd = ldd;
            if (t + G < F8) { const int tn = t + G; TILE_DESC(tn, src, lds_, dst, ldd);
#pragma unroll
                for (int i = 0; i < 8; ++i) rv[i] = *(const f32x4*)(src + (size_t)(kk0 + 32 * i) * lds_ + c4 * 4); }
#pragma unroll
            for (int i = 0; i < 4; ++i) { const int n = (tid >> 5) + 16 * i, k8 = (tid & 31) * 8; const LAS float* s2 = sm + n * 257 + k8;
              u32x4 w; w.x = pk2(s2[0], s2[1]); w.y = pk2(s2[2], s2[3]); w.z = pk2(s2[4], s2[5]); w.w = pk2(s2[6], s2[7]);
              if (cldd > 0) *(u32x4*)(cdst + (size_t)n * cldd + k8) = w;
              else { bf16_t* vd = cdst + (size_t)(k8 >> 5) * 2048 + n * 32 + ((k8 & 31) >> 3) * 4; u32x2 a; a.x = w.x; a.y = w.y; u32x2 b2; b2.x = w.z; b2.y = w.w; *(u32x2*)vd = a; *(u32x2*)(vd + 16) = b2; } }
            __syncthreads();
        }
    }
#undef TILE_DESC
    { bf16_t* ks = (bf16_t*)(ws + WS_KS);
      for (size_t i = (size_t)bx * 512 + tid; i < (size_t)SB * PAST * D / 8; i += (size_t)G * 512) {
          const size_t e = i * 8; const int b = (int)(e / ((size_t)PAST * D)); const size_t r = e % ((size_t)PAST * D);
          const f32x4 a = *(const f32x4*)(p.cache_k + e), c = *(const f32x4*)(p.cache_k + e + 4);
          const int pos = (int)(r >> 10), hh = (int)(r >> 6) & 15, dd = (int)r & 63;
          *(u32x4*)(ks + (((size_t)b * NH + hh) * SKV + pos) * HD + dd) = pk8(a, c); } }
    for (int job = bx; job < NMOD / 32; job += G) {
        __syncthreads();
        for (int i = tid; i < 24 * D; i += 512) { const int r = i >> 10, k = i & 1023; const float c = r < 16 ? p.c_prompt[r * D + k] : p.c_sample[(r - 16) * D + k]; sm[i] = c / (1.0f + __expf(-c)); }
        __syncthreads();
        const int n = tid & 31, kq = tid >> 5, col = job * 32 + n;
        float a[24];
#pragma unroll
        for (int r = 0; r < 24; ++r) a[r] = 0.f;
        for (int k0 = kq * 64; k0 < kq * 64 + 64; k0 += 16) { float wv[16];
#pragma unroll
            for (int kk = 0; kk < 16; ++kk) wv[kk] = p.w_ada[(size_t)(k0 + kk) * NMOD + col];
#pragma unroll
            for (int kk = 0; kk < 16; ++kk)
#pragma unroll
                for (int r = 0; r < 24; ++r) a[r] += sm[r * D + k0 + kk] * wv[kk]; }
        __syncthreads();
#pragma unroll
        for (int r = 0; r < 24; ++r) sm[(kq * 24 + r) * 32 + n] = a[r];
        __syncthreads();
        for (int i = tid; i < 24 * 32; i += 512) { const int r = i >> 5, nn = i & 31; float s = p.b_ada[job * 32 + nn];
            for (int q = 0; q < 16; ++q) s += sm[(q * 24 + r) * 32 + nn];
            ((float*)(ws + WS_MOD))[(size_t)r * NMOD + job * 32 + nn] = s; }
    }
    __syncthreads();
}

DI void phase_norm_mod(const float* srcP, const float* srcS, const float* g, const float* mod, int shift_off, bf16_t* dst, int gw, int nw, int lane) {
    f32x4 gv[4];
#pragma unroll
    for (int i = 0; i < 4; ++i) gv[i] = *(const f32x4*)(g + lane * 4 + 256 * i);
    f32x4 cur[2][4], nxt[2][4];
#define NM_LOAD(dstv, r0) do { _Pragma("unroll") for (int rr = 0; rr < 2; ++rr) { const int row_ = (r0) + rr * nw; if (row_ < M) { \
        const float* s_ = row_ < MP ? srcP + (size_t)row_ * D : srcS + (size_t)(row_ - MP) * D; \
        _Pragma("unroll") for (int i = 0; i < 4; ++i) dstv[rr][i] = *(const f32x4*)(s_ + lane * 4 + 256 * i); } } } while (0)
    NM_LOAD(cur, gw);
    for (int row0 = gw; row0 < M; row0 += 2 * nw) {
        NM_LOAD(nxt, row0 + 2 * nw);
        f32x4 msh[4], msc[4];
        { const float* mp = mod + (size_t)bidx_of(row0) * NMOD + shift_off;
#pragma unroll
          for (int i = 0; i < 4; ++i) { const int c = lane * 4 + 256 * i; msh[i] = *(const f32x4*)(mp + c); msc[i] = *(const f32x4*)(mp + D + c); } }
#pragma unroll
        for (int rr = 0; rr < 2; ++rr) { const int row = row0 + rr * nw; if (row < M) {
            float ss = 0.f;
#pragma unroll
            for (int i = 0; i < 4; ++i) ss += cur[rr][i][0] * cur[rr][i][0] + cur[rr][i][1] * cur[rr][i][1] + cur[rr][i][2] * cur[rr][i][2] + cur[rr][i][3] * cur[rr][i][3];
#pragma unroll
            for (int o = 32; o >= 1; o >>= 1) ss += __shfl_xor(ss, o);
            const float rstd = rsqrtf(ss * (1.0f / D) + 1e-6f);
            if (rr == 1 && bidx_of(row) != bidx_of(row0)) { const float* mp = mod + (size_t)bidx_of(row) * NMOD + shift_off;
#pragma unroll
                for (int i = 0; i < 4; ++i) { const int c = lane * 4 + 256 * i; msh[i] = *(const f32x4*)(mp + c); msc[i] = *(const f32x4*)(mp + D + c); } }
#pragma unroll
            for (int i = 0; i < 4; ++i) { const int c = lane * 4 + 256 * i; const f32x4 sh = msh[i], sc = msc[i];
                const f32x4 h = cur[rr][i] * rstd * gv[i] * (sc + 1.0f) + sh;
                u32x2 w; w.x = pk2(h[0], h[1]); w.y = pk2(h[2], h[3]); *(u32x2*)(dst + (size_t)row * D + c) = w; } } }
#pragma unroll
        for (int rr = 0; rr < 2; ++rr)
#pragma unroll
            for (int i = 0; i < 4; ++i) cur[rr][i] = nxt[rr][i];
    }
#undef NM_LOAD
}
DI void phase_final_norm(float* y, const float* g, int gw, int nw, int lane) {
    f32x4 gv[4];
#pragma unroll
    for (int i = 0; i < 4; ++i) gv[i] = *(const f32x4*)(g + lane * 4 + 256 * i);
    f32x4 cur[2][4], nxt[2][4];
#define NM_LOAD(dstv, r0) do { _Pragma("unroll") for (int rr = 0; rr < 2; ++rr) { const int row_ = (r0) + rr * nw; if (row_ < M) { \
        const float* s_ = y + (size_t)row_ * D; \
        _Pragma("unroll") for (int i = 0; i < 4; ++i) dstv[rr][i] = *(const f32x4*)(s_ + lane * 4 + 256 * i); } } } while (0)
    NM_LOAD(cur, gw);
    for (int row0 = gw; row0 < M; row0 += 2 * nw) {
        NM_LOAD(nxt, row0 + 2 * nw);
#pragma unroll
        for (int rr = 0; rr < 2; ++rr) { const int row = row0 + rr * nw; if (row < M) {
            float ss = 0.f;
#pragma unroll
            for (int i = 0; i < 4; ++i) ss += cur[rr][i][0] * cur[rr][i][0] + cur[rr][i][1] * cur[rr][i][1] + cur[rr][i][2] * cur[rr][i][2] + cur[rr][i][3] * cur[rr][i][3];
#pragma unroll
            for (int o = 32; o >= 1; o >>= 1) ss += __shfl_xor(ss, o);
            const float rstd = rsqrtf(ss * (1.0f / D) + 1e-6f);
#pragma unroll
            for (int i = 0; i < 4; ++i) *(f32x4*)(y + (size_t)row * D + lane * 4 + 256 * i) = cur[rr][i] * rstd * gv[i]; } }
#pragma unroll
        for (int rr = 0; rr < 2; ++rr)
#pragma unroll
            for (int i = 0; i < 4; ++i) cur[rr][i] = nxt[rr][i];
    }
#undef NM_LOAD
}

template <int MODE> DI void phase_norm_b(const bf16_t* src, const float* g, const float* mod, int shift_off, bf16_t* dst, float* dstf, int gw, int nw, int lane) {
    f32x4 gv[4];
#pragma unroll
    for (int i = 0; i < 2; ++i) { gv[2 * i] = *(const f32x4*)(g + lane * 8 + 512 * i); gv[2 * i + 1] = *(const f32x4*)(g + lane * 8 + 512 * i + 4); }
    u32x4 cur[4][2], nxt[4][2];
#define NB_LOAD(dstv, r0) do { _Pragma("unroll") for (int rr = 0; rr < 4; ++rr) { const int row_ = (r0) + rr * nw; if (row_ < M) { \
        _Pragma("unroll") for (int i = 0; i < 2; ++i) dstv[rr][i] = *(const u32x4*)(src + (size_t)row_ * D + lane * 8 + 512 * i); } } } while (0)
    NB_LOAD(cur, gw);
    for (int row0 = gw; row0 < M; row0 += 4 * nw) {
        NB_LOAD(nxt, row0 + 4 * nw);
        f32x4 msh[2][4], msc[2][4];
        if (MODE == 0) {
#pragma unroll
            for (int pr = 0; pr < 2; ++pr) { const int row_ = row0 + 2 * pr * nw; if (row_ < M) { const float* mp = mod + (size_t)bidx_of(row_) * NMOD + shift_off;
#pragma unroll
                for (int i = 0; i < 2; ++i) { const int c = lane * 8 + 512 * i; msh[pr][2 * i] = *(const f32x4*)(mp + c); msh[pr][2 * i + 1] = *(const f32x4*)(mp + c + 4); msc[pr][2 * i] = *(const f32x4*)(mp + D + c); msc[pr][2 * i + 1] = *(const f32x4*)(mp + D + c + 4); } } }
        }
#pragma unroll
        for (int rr = 0; rr < 4; ++rr) { const int row = row0 + rr * nw; if (row < M) {
            f32x4 v[4];
#pragma unroll
            for (int i = 0; i < 2; ++i) { const u32x4 w = cur[rr][i]; v[2 * i] = (f32x4){bflo(w.x), bfhi(w.x), bflo(w.y), bfhi(w.y)}; v[2 * i + 1] = (f32x4){bflo(w.z), bfhi(w.z), bflo(w.w), bfhi(w.w)}; }
            float ss = 0.f;
#pragma unroll
            for (int i = 0; i < 4; ++i) ss += v[i][0] * v[i][0] + v[i][1] * v[i][1] + v[i][2] * v[i][2] + v[i][3] * v[i][3];
#pragma unroll
            for (int o = 32; o >= 1; o >>= 1) ss += __shfl_xor(ss, o);
            const float rstd = rsqrtf(ss * (1.0f / D) + 1e-6f);
            if (MODE == 0) {
                if ((rr & 1) && bidx_of(row) != bidx_of(row - nw)) {
                    const float* mp = mod + (size_t)bidx_of(row) * NMOD + shift_off;
#pragma unroll
                    for (int i = 0; i < 2; ++i) { const int c = lane * 8 + 512 * i; msh[rr >> 1][2 * i] = *(const f32x4*)(mp + c); msh[rr >> 1][2 * i + 1] = *(const f32x4*)(mp + c + 4); msc[rr >> 1][2 * i] = *(const f32x4*)(mp + D + c); msc[rr >> 1][2 * i + 1] = *(const f32x4*)(mp + D + c + 4); } }
#pragma unroll
                for (int i = 0; i < 2; ++i) { const int c = lane * 8 + 512 * i;
                    const f32x4 h0 = v[2 * i] * rstd * gv[2 * i] * (msc[rr >> 1][2 * i] + 1.0f) + msh[rr >> 1][2 * i];
                    const f32x4 h1 = v[2 * i + 1] * rstd * gv[2 * i + 1] * (msc[rr >> 1][2 * i + 1] + 1.0f) + msh[rr >> 1][2 * i + 1];
                    *(u32x4*)(dst + (size_t)row * D + c) = pk8(h0, h1); }
            } else {
#pragma unroll
                for (int i = 0; i < 2; ++i) { const int c = lane * 8 + 512 * i;
                    *(f32x4*)(dstf + (size_t)row * D + c) = v[2 * i] * rstd * gv[2 * i]; *(f32x4*)(dstf + (size_t)row * D + c + 4) = v[2 * i + 1] * rstd * gv[2 * i + 1]; }
            } } }
#pragma unroll
        for (int rr = 0; rr < 4; ++rr)
#pragma unroll
            for (int i = 0; i < 2; ++i) cur[rr][i] = nxt[rr][i];
    }
#undef NB_LOAD
}

DI void phase_ob(const Params& p, bf16_t* bg, const bf16_t* cu, int gw, int nw, int lane) {
    for (int item = gw; item < (M / 16) * 2; item += nw) {
        const int half = item & 1, row0 = (item >> 1) * 16, ch = half * 512 + lane * 8;
        float w0[8], w1[8], w2[8], bb[8], p2[8], p1[8];
#pragma unroll
        for (int j = 0; j < 8; ++j) { w0[j] = p.w_conv[ch + j]; w1[j] = p.w_conv[D + ch + j]; w2[j] = p.w_conv[2 * D + ch + j]; bb[j] = p.b_conv[ch + j]; }
        const bool start = row0 < MP ? ((row0 & (T - 1)) == 0) : (((row0 - MP) & 31) == 0);
        if (start) {
            if (row0 < MP) {
#pragma unroll
                for (int j = 0; j < 8; ++j) { p2[j] = 0.f; p1[j] = 0.f; } }
            else { const float* sc = p.state_conv + (size_t)((row0 - MP) >> 5) * 2 * D + ch;
#pragma unroll
                for (int j = 0; j < 8; ++j) { p2[j] = sc[j]; p1[j] = sc[D + j]; } }
        } else {
            const u32x4 a = *(const u32x4*)(cu + (size_t)(row0 - 2) * D + ch), b = *(const u32x4*)(cu + (size_t)(row0 - 1) * D + ch);
            p2[0] = bflo(a.x); p2[1] = bfhi(a.x); p2[2] = bflo(a.y); p2[3] = bfhi(a.y); p2[4] = bflo(a.z); p2[5] = bfhi(a.z); p2[6] = bflo(a.w); p2[7] = bfhi(a.w);
            p1[0] = bflo(b.x); p1[1] = bfhi(b.x); p1[2] = bflo(b.y); p1[3] = bfhi(b.y); p1[4] = bflo(b.z); p1[5] = bfhi(b.z); p1[6] = bflo(b.w); p1[7] = bfhi(b.w);
        }
#pragma unroll
        for (int rb = 0; rb < 16; rb += 8) {
            u32x4 cc[8], gq[8];
#pragma unroll
            for (int r = 0; r < 8; ++r) { const size_t o = (size_t)(row0 + rb + r) * D + ch; cc[r] = *(const u32x4*)(cu + o); gq[r] = *(const u32x4*)(bg + o); }
#pragma unroll
            for (int r = 0; r < 8; ++r) {
                const u32x4 c = cc[r], q4 = gq[r];
                float cur[8] = {bflo(c.x), bfhi(c.x), bflo(c.y), bfhi(c.y), bflo(c.z), bfhi(c.z), bflo(c.w), bfhi(c.w)};
                float gg[8] = {bflo(q4.x), bfhi(q4.x), bflo(q4.y), bfhi(q4.y), bflo(q4.z), bfhi(q4.z), bflo(q4.w), bfhi(q4.w)};
                float y[8];
#pragma unroll
                for (int j = 0; j < 8; ++j) { y[j] = gg[j] * (w0[j] * p2[j] + w1[j] * p1[j] + w2[j] * cur[j] + bb[j]); p2[j] = p1[j]; p1[j] = cur[j]; }
                u32x4 w; w.x = pk2(y[0], y[1]); w.y = pk2(y[2], y[3]); w.z = pk2(y[4], y[5]); w.w = pk2(y[6], y[7]);
                *(u32x4*)(bg + (size_t)(row0 + rb + r) * D + ch) = w;
            }
        }
    }
}
DI void phase_act_fix(const Params& p, bf16_t* act, const bf16_t* hup, const bf16_t* hgt, const bf16_t* tup, const bf16_t* ugs, int gw, int nw, int lane) {
    constexpr int NSTRIP = MP / 64, NFIX = NSTRIP * 6, NSMP = (MS / 16) * 11;
    for (int item = gw; item < NFIX + NSMP; item += nw) {
        if (item < NFIX) {
            const int strip = item / 6, slab = item % 6, ch = slab * 512 + lane * 8;
            if (ch >= DFF) continue;
            float w0[8], w1[8], w2[8], bb[8], p2[8], p1[8], c0[8], c1[8], g0[8], g1[8];
#pragma unroll
            for (int j = 0; j < 8; ++j) { w0[j] = p.w_fconv[ch + j]; w1[j] = p.w_fconv[DFF + ch + j]; w2[j] = p.w_fconv[2 * DFF + ch + j]; bb[j] = p.b_fconv[ch + j]; }
            if ((strip & 63) == 0) {
#pragma unroll
                for (int j = 0; j < 8; ++j) { p2[j] = 0.f; p1[j] = 0.f; } }
            else { unpack8(*(const u32x4*)(tup + ((size_t)(strip - 1) * 2) * DFF + ch), p2); unpack8(*(const u32x4*)(tup + ((size_t)(strip - 1) * 2 + 1) * DFF + ch), p1); }
            unpack8(*(const u32x4*)(hup + ((size_t)strip * 2) * DFF + ch), c0); unpack8(*(const u32x4*)(hup + ((size_t)strip * 2 + 1) * DFF + ch), c1);
            unpack8(*(const u32x4*)(hgt + ((size_t)strip * 2) * DFF + ch), g0); unpack8(*(const u32x4*)(hgt + ((size_t)strip * 2 + 1) * DFF + ch), g1);
            float y0[8], y1[8];
#pragma unroll
            for (int j = 0; j < 8; ++j) { const float ua = w0[j] * p2[j] + w1[j] * p1[j] + w2[j] * c0[j] + bb[j], ub = w0[j] * p1[j] + w1[j] * c0[j] + w2[j] * c1[j] + bb[j];
                y0[j] = g0[j] * ua / (1.0f + __expf(-ua)); y1[j] = g1[j] * ub / (1.0f + __expf(-ub)); }
            u32x4 a, b; a.x = pk2(y0[0], y0[1]); a.y = pk2(y0[2], y0[3]); a.z = pk2(y0[4], y0[5]); a.w = pk2(y0[6], y0[7]);
            b.x = pk2(y1[0], y1[1]); b.y = pk2(y1[2], y1[3]); b.z = pk2(y1[4], y1[5]); b.w = pk2(y1[6], y1[7]);
            *(u32x4*)(act + (size_t)(strip * 64) * DFF + ch) = a; *(u32x4*)(act + (size_t)(strip * 64 + 1) * DFF + ch) = b;
        } else {
            const int q = item - NFIX, slab = q % 11, row0 = (q / 11) * 16, ch = slab * 256 + lane * 4;
            float w0[4], w1[4], w2[4], bb[4], p2[4], p1[4];
#pragma unroll
            for (int j = 0; j < 4; ++j) { w0[j] = p.w_fconv[ch + j]; w1[j] = p.w_fconv[DFF + ch + j]; w2[j] = p.w_fconv[2 * DFF + ch + j]; bb[j] = p.b_fconv[ch + j]; }
            if ((row0 & 31) == 0) { const float* sc = p.state_ffn + (size_t)(row0 >> 5) * 2 * DFF + ch;
#pragma unroll
                for (int j = 0; j < 4; ++j) { p2[j] = sc[j]; p1[j] = sc[DFF + j]; } }
            else { const u32x2 a = *(const u32x2*)(ugs + (size_t)(row0 - 2) * (2 * DFF) + ch), b = *(const u32x2*)(ugs + (size_t)(row0 - 1) * (2 * DFF) + ch);
                p2[0] = bflo(a.x); p2[1] = bfhi(a.x); p2[2] = bflo(a.y); p2[3] = bfhi(a.y); p1[0] = bflo(b.x); p1[1] = bfhi(b.x); p1[2] = bflo(b.y); p1[3] = bfhi(b.y); }
            u32x2 cc[16], gq[16];
#pragma unroll
            for (int r = 0; r < 16; ++r) { const size_t o = (size_t)(row0 + r) * (2 * DFF) + ch; cc[r] = *(const u32x2*)(ugs + o); gq[r] = *(const u32x2*)(ugs + o + DFF); }
#pragma unroll
            for (int r = 0; r < 16; ++r) {
                const u32x2 c = cc[r], q2 = gq[r];
                float cur[4] = {bflo(c.x), bfhi(c.x), bflo(c.y), bfhi(c.y)};
                float gg[4] = {bflo(q2.x), bfhi(q2.x), bflo(q2.y), bfhi(q2.y)};
                float y[4];
#pragma unroll
                for (int j = 0; j < 4; ++j) { const float uc = w0[j] * p2[j] + w1[j] * p1[j] + w2[j] * cur[j] + bb[j]; y[j] = gg[j] * uc / (1.0f + __expf(-uc)); p2[j] = p1[j]; p1[j] = cur[j]; }
                u32x2 w; w.x = pk2(y[0], y[1]); w.y = pk2(y[2], y[3]);
                *(u32x2*)(act + (size_t)(MP + row0 + r) * DFF + ch) = w;
            }
        }
    }
}


#define MFMA32(a, b, c) __builtin_amdgcn_mfma_f32_32x32x16_bf16((a), (b), (c), 0, 0, 0)
DI void sg_mma(f32x16& acc, const bf16_t* X, int ldx, const bf16_t* Y, int ldy, int K, int lane) {
    const bf16_t* xp = X + (size_t)(lane & 31) * ldx + 8 * (lane >> 5);
    const bf16_t* yp = Y + (size_t)(lane & 31) * ldy + 8 * (lane >> 5);
    for (int k0 = 0; k0 < K; k0 += 128) {
        bf16x8 xa[8], yb[8];
#pragma unroll
        for (int s2 = 0; s2 < 8; ++s2) { xa[s2] = *(const bf16x8*)(xp + k0 + 16 * s2); yb[s2] = *(const bf16x8*)(yp + k0 + 16 * s2); }
#pragma unroll
        for (int s2 = 0; s2 < 8; ++s2) acc = MFMA32(xa[s2], yb[s2], acc);
    }
}
DI f32x16 zero16() { f32x16 z;
#pragma unroll
    for (int e = 0; e < 16; ++e) z[e] = 0.f; return z; }
DI void st_bf4(bf16_t* p, float a, float b, float c, float d) { u32x2 w; w.x = pk2(a, b); w.y = pk2(c, d); *(u32x2*)p = w; }

DI void sample_p2(const bf16_t* hbuf, const bf16_t* Win, const bf16_t* Wv, bf16_t* q, bf16_t* ks, bf16_t* vts, bf16_t* bg, bf16_t* cu, bf16_t* sga, bf16_t* sgb, float* out, int gw, int lane) {
    if (gw >= 7 * 256) return;
    const int kind = gw >> 8, b = (gw >> 5) & 7, j = gw & 31, hf = lane >> 5, tl = lane & 31;
    const bf16_t* hrow = hbuf + (size_t)(MP + 32 * b) * D;
    const int row = MP + 32 * b + tl, rs = 32 * b + tl;
    if (kind == 6) {
        f32x16 acc = zero16(); sg_mma(acc, hrow, D, Wv + (size_t)(32 * j) * D, D, D, lane);
        const int dch = 32 * j + tl, hh = dch >> 6, dd = dch & 63;
#pragma unroll
        for (int g = 0; g < 4; ++g) {
            st_bf4(vts + (((size_t)b * NH + hh) * (SKV / 32) + PAST / 32) * 2048 + dd * 32 + 16 * hf + 4 * g, acc[4 * g], acc[4 * g + 1], acc[4 * g + 2], acc[4 * g + 3]);
#pragma unroll
            for (int e = 0; e < 4; ++e) out[O_VS + (size_t)(32 * b + 8 * g + 4 * hf + e) * D + dch] = acc[4 * g + e];
        }
        return;
    }
    if (kind == 3) {
        const int c0 = 32 * j, vC = 3072 + 256 * (c0 >> 7) + (c0 & 127);
        f32x16 aC = zero16(), aU = zero16();
        sg_mma(aC, Win + (size_t)vC * D, D, hrow, D, D, lane); sg_mma(aU, Win + (size_t)(vC + 128) * D, D, hrow, D, D, lane);
#pragma unroll
        for (int g = 0; g < 4; ++g) { const int c = c0 + 8 * g + 4 * hf; f32x4 pr = {aC[4 * g] * aU[4 * g], aC[4 * g + 1] * aU[4 * g + 1], aC[4 * g + 2] * aU[4 * g + 2], aC[4 * g + 3] * aU[4 * g + 3]};
            st_bf4(cu + (size_t)row * D + c, pr[0], pr[1], pr[2], pr[3]);
            if (tl >= ST - 2) *(f32x4*)(out + O_CS + ((size_t)b * 2 + (tl - (ST - 2))) * D + c) = pr; }
        return;
    }
    const int vbase = kind == 0 ? 0 : (kind == 1 ? 1024 : (kind == 2 ? 2048 : (kind == 4 ? 5120 : 6144)));
    f32x16 acc = zero16(); sg_mma(acc, Win + (size_t)(vbase + 32 * j) * D, D, hrow, D, D, lane);
#pragma unroll
    for (int g = 0; g < 4; ++g) { const int n = 32 * j + 8 * g + 4 * hf; const float a0 = acc[4 * g], a1 = acc[4 * g + 1], a2 = acc[4 * g + 2], a3 = acc[4 * g + 3];
        if (kind == 0) st_bf4(q + (size_t)row * D + n, a0 * QSCALE, a1 * QSCALE, a2 * QSCALE, a3 * QSCALE);
        else if (kind == 1) { st_bf4(ks + (((size_t)b * NH + (n >> 6)) * SKV + PAST + tl) * HD + (n & 63), a0, a1, a2, a3); *(f32x4*)(out + O_KS + (size_t)rs * D + n) = (f32x4){a0, a1, a2, a3}; }
        else if (kind == 2) st_bf4(bg + (size_t)row * D + n, a0, a1, a2, a3);
        else st_bf4((kind == 4 ? sga : sgb) + (size_t)row * D + n, sigmoidf_(a0), sigmoidf_(a1), sigmoidf_(a2), sigmoidf_(a3)); }
}
DI void sample_p4(const bf16_t* oa, const bf16_t* ob, const bf16_t* Wa, const bf16_t* Wb, const bf16_t* sga, const bf16_t* sgb, bf16_t* merged, int job, int lane) {
    const int b = job >> 5, j = job & 31, hf = lane >> 5, tl = lane & 31, row = MP + 32 * b + tl;
    f32x16 aA = zero16(), aB = zero16();
    sg_mma(aA, Wa + (size_t)(32 * j) * D, D, oa + (size_t)(MP + 32 * b) * D, D, D, lane); sg_mma(aB, Wb + (size_t)(32 * j) * D, D, ob + (size_t)(MP + 32 * b) * D, D, D, lane);
#pragma unroll
    for (int g = 0; g < 4; ++g) { const size_t o = (size_t)row * D + 32 * j + 8 * g + 4 * hf; const u32x2 sa = *(const u32x2*)(sga + o), sb = *(const u32x2*)(sgb + o);
        st_bf4(merged + o, bflo(sa.x) * aA[4 * g] + bflo(sb.x) * aB[4 * g], bfhi(sa.x) * aA[4 * g + 1] + bfhi(sb.x) * aB[4 * g + 1],
               bflo(sa.y) * aA[4 * g + 2] + bflo(sb.y) * aB[4 * g + 2], bfhi(sa.y) * aA[4 * g + 3] + bfhi(sb.y) * aB[4 * g + 3]); }
}
template <int MODE> DI void sample_res(const bf16_t* A, int lda, const bf16_t* W, int K, const float* xs, const float* gate, bf16_t* xb, int job, int lane) {
    const int b = job >> 5, j = job & 31, hf = lane >> 5, tl = lane & 31;
    f32x16 acc = zero16(); sg_mma(acc, W + (size_t)(32 * j) * K, K, A + (size_t)(MP + 32 * b) * lda, lda, K, lane);
    const float* gp = gate + (size_t)(16 + b) * NMOD;
#pragma unroll
    for (int g = 0; g < 4; ++g) { const int n = 32 * j + 8 * g + 4 * hf; const f32x4 a = {acc[4 * g], acc[4 * g + 1], acc[4 * g + 2], acc[4 * g + 3]};
        bf16_t* dp = xb + (size_t)(MP + 32 * b + tl) * D + n; f32x4 x;
        if (MODE == 0) x = *(const f32x4*)(xs + (size_t)(32 * b + tl) * D + n);
        else { const u32x2 w = *(const u32x2*)dp; x = (f32x4){bflo(w.x), bfhi(w.x), bflo(w.y), bfhi(w.y)}; }
        const f32x4 r = x + *(const f32x4*)(gp + n) * a; st_bf4(dp, r[0], r[1], r[2], r[3]); }
}
DI void sample_up(const bf16_t* h2, const bf16_t* Wup, bf16_t* ugs, float* out, int gw, int lane) {
    if (gw >= 1408) return;
    const int isg = gw >= 704 ? 1 : 0, r = gw - 704 * isg, b = r / 88, j = r % 88, hf = lane >> 5, tl = lane & 31, c0 = 32 * j;
    const int vrow = 256 * (c0 >> 7) + (c0 & 127) + 128 * isg;
    f32x16 acc = zero16(); sg_mma(acc, Wup + (size_t)vrow * D, D, h2 + (size_t)(MP + 32 * b) * D, D, D, lane);
#pragma unroll
    for (int g = 0; g < 4; ++g) { const int c = c0 + 8 * g + 4 * hf;
        st_bf4(ugs + (size_t)(32 * b + tl) * (2 * DFF) + DFF * isg + c, acc[4 * g], acc[4 * g + 1], acc[4 * g + 2], acc[4 * g + 3]);
        if (!isg && tl >= ST - 2) *(f32x4*)(out + O_FS + ((size_t)b * 2 + (tl - (ST - 2))) * DFF + c) = (f32x4){acc[4 * g], acc[4 * g + 1], acc[4 * g + 2], acc[4 * g + 3]}; }
}

DI void phase_attn(bf16_t* qo, const bf16_t* kbuf, const bf16_t* vT, const bf16_t* ks, const bf16_t* vts, LAS unsigned char* lds, int wid, int gw, int nw, int lane) {
    const int hf = lane >> 5, tl = lane & 31;
    LAS unsigned char* myl = lds + wid * (32 * 144);
    constexpr int NITEM = NB * NH * (T / 32) + SB * NH;
    for (int item = gw; item < NITEM; item += nw) {
        int qt, h, qrow0; const bf16_t *K, *VT;
        if (item < NB * NH * (T / 32)) { qt = item & 127; h = (item >> 7) & 15; const int b = item >> 11; qrow0 = b * T + qt * 32;
            K = kbuf + ((size_t)(b * NH + h) * T) * HD; VT = vT + ((size_t)(b * NH + h) * (T / 32)) * 2048; }
        else { const int s = item - NB * NH * (T / 32); h = s & 15; const int b = s >> 4; qt = PAST / 32; qrow0 = MP + b * ST;
            K = ks + ((size_t)(b * NH + h) * SKV) * HD; VT = vts + ((size_t)(b * NH + h) * (SKV / 32)) * 2048; }
        bf16x8 qf[4];
        { const bf16_t* qp = qo + (size_t)(qrow0 + tl) * D + h * HD + 8 * hf;
#pragma unroll
          for (int s = 0; s < 4; ++s) qf[s] = *(const bf16x8*)(qp + 16 * s); }
        f32x16 O0, O1;
#pragma unroll
        for (int e = 0; e < 16; ++e) { O0[e] = 0.f; O1[e] = 0.f; }
        float carry = 0.f;
        bf16x8 kfA[4], vrA[2][2], kfB[4], vrB[2][2];
#define AT_LOAD(kfd, vrd, kb_) do { const bf16_t* kp_ = K + (size_t)((kb_) * 32 + tl) * HD + 8 * hf; const bf16_t* vp_ = VT + (size_t)(kb_) * 2048 + tl * 32 + hf * 16; \
        _Pragma("unroll") for (int s = 0; s < 4; ++s) kfd[s] = *(const bf16x8*)(kp_ + 16 * s); \
        _Pragma("unroll") for (int dt = 0; dt < 2; ++dt) _Pragma("unroll") for (int s = 0; s < 2; ++s) vrd[dt][s] = *(const bf16x8*)(vp_ + dt * 1024 + s * 8); } while (0)
#define AT_BLOCK(kf, vr, kfn, vrn, kb_, done_) do { \
            if ((kb_) > 0) AT_LOAD(kfn, vrn, (kb_) - 1); \
            f32x16 z = MFMA32(kf[0], qf[0], zc); \
            _Pragma("unroll") for (int s = 1; s < 4; ++s) z = MFMA32(kf[s], qf[s], z); \
            const bool diag = ((kb_) == qt); \
            float L[16]; \
            _Pragma("unroll") for (int e = 0; e < 16; ++e) { const float zz = z[e]; const float ex = __builtin_amdgcn_exp2f(-fabsf(zz)); \
                float l = -(__builtin_amdgcn_fmed3f(zz, 0.f, __builtin_inff()) + __builtin_amdgcn_logf(1.0f + ex)); \
                if (diag) { const int key = 8 * (e >> 2) + 4 * hf + (e & 3); if (key >= tl) l = 0.f; } \
                L[e] = l; } \
            float Gs[4], Gp[4]; \
            _Pragma("unroll") for (int g = 0; g < 4; ++g) { Gs[g] = (L[4 * g] + L[4 * g + 1]) + (L[4 * g + 2] + L[4 * g + 3]); Gp[g] = __shfl_xor(Gs[g], 32); } \
            float Tt[5]; Tt[4] = 0.f; \
            _Pragma("unroll") for (int g = 3; g >= 0; --g) Tt[g] = Tt[g + 1] + (Gs[g] + Gp[g]); \
            float a[16]; \
            _Pragma("unroll") for (int g = 0; g < 4; ++g) { \
                const float s3 = Tt[g + 1] + (hf == 0 ? Gp[g] : 0.f) + carry; \
                const float s2 = s3 + L[4 * g + 3], s1 = s2 + L[4 * g + 2], s0 = s1 + L[4 * g + 1]; \
                a[4 * g + 3] = __builtin_amdgcn_exp2f(z[4 * g + 3] + L[4 * g + 3] + s3); a[4 * g + 2] = __builtin_amdgcn_exp2f(z[4 * g + 2] + L[4 * g + 2] + s2); \
                a[4 * g + 1] = __builtin_amdgcn_exp2f(z[4 * g + 1] + L[4 * g + 1] + s1); a[4 * g] = __builtin_amdgcn_exp2f(z[4 * g] + L[4 * g] + s0); } \
            if (diag) { _Pragma("unroll") for (int e = 0; e < 16; ++e) { const int key = 8 * (e >> 2) + 4 * hf + (e & 3); if (key >= tl) a[e] = 0.f; } } \
            carry += Tt[0]; \
            _Pragma("unroll") for (int s = 0; s < 2; ++s) { \
                u32x4 aw; aw.x = pk2(a[8 * s], a[8 * s + 1]); aw.y = pk2(a[8 * s + 2], a[8 * s + 3]); aw.z = pk2(a[8 * s + 4], a[8 * s + 5]); aw.w = pk2(a[8 * s + 6], a[8 * s + 7]); \
                const bf16x8 af = __builtin_bit_cast(bf16x8, aw); \
                O0 = MFMA32(vr[0][s], af, O0); O1 = MFMA32(vr[1][s], af, O1); } \
              \
            done_ = ((kb_) == 0) || __all(carry < -151.0f); } while (0)
        const f32x16 zc = zero16();
        AT_LOAD(kfA, vrA, qt);
        for (int kb = qt; kb >= 0; kb -= 2) {
            bool done;
            AT_BLOCK(kfA, vrA, kfB, vrB, kb, done);
            if (done) break;
            AT_BLOCK(kfB, vrB, kfA, vrA, kb - 1, done);
            if (done) break;
        }
#undef AT_BLOCK
#undef AT_LOAD
#pragma unroll
        for (int g = 0; g < 4; ++g) {
            u32x2 w0; w0.x = pk2(O0[4 * g], O0[4 * g + 1]); w0.y = pk2(O0[4 * g + 2], O0[4 * g + 3]);
            u32x2 w1; w1.x = pk2(O1[4 * g], O1[4 * g + 1]); w1.y = pk2(O1[4 * g + 2], O1[4 * g + 3]);
            *(LAS u32x2*)(myl + tl * 144 + (8 * g + 4 * hf) * 2) = w0;
            *(LAS u32x2*)(myl + tl * 144 + (32 + 8 * g + 4 * hf) * 2) = w1;
        }
        asm volatile("s_waitcnt lgkmcnt(0)" ::: "memory");
#pragma unroll
        for (int it = 0; it < 4; ++it) { const int chunk = it * 64 + lane, row = chunk >> 3, c16 = chunk & 7;
            const u32x4 w = *(const LAS u32x4*)(myl + row * 144 + c16 * 16);
            *(u32x4*)(qo + (size_t)(qrow0 + row) * D + h * HD + c16 * 8) = w; }
        asm volatile("s_waitcnt lgkmcnt(0)" ::: "memory");
    }
}

#define XB_TMO      128
#define XB_XCNT(j)  (256  + 64 * (j))
#define XB_XSUB(j)  (1280 + 64 * (j))
#define XB_XGEN(j)  (2304 + 64 * (j))
#define XB_TOP      3328
#define XB_TOPGEN   3392
#define XCD_BAR_WORDS 3456
#define XB_SPIN_CAP (1u << 18)
DI unsigned xb_ld(unsigned* p) { return __hip_atomic_load(p, __ATOMIC_RELAXED, __HIP_MEMORY_SCOPE_AGENT); }
DI unsigned xb_add(unsigned* p, unsigned v) { return __hip_atomic_fetch_add(p, v, __ATOMIC_RELAXED, __HIP_MEMORY_SCOPE_AGENT); }
DI unsigned xb_xcc_id() { return (unsigned)__builtin_amdgcn_s_getreg((3 << 11) | 20) & 0xFu; }
#define XB_SPIN(cond, bar) do { unsigned _sp = 0; while (cond) { __builtin_amdgcn_s_sleep(1); \
    if ((++_sp & 255u) == 0u) { if (xb_ld(&(bar)[XB_TMO])) break; if (_sp > XB_SPIN_CAP) { atomicAdd(&(bar)[XB_TMO], 1u); break; } } } } while (0)
struct XcdBarrier { unsigned* bar; unsigned x; volatile LAS unsigned* st; };
DI XcdBarrier xcd_barrier_post(unsigned* bar, volatile LAS unsigned* st) {
    XcdBarrier b; b.bar = bar; b.x = xb_xcc_id(); b.st = st;
    if (threadIdx.x == 0) (void)xb_add(&bar[XB_XCNT(b.x)], 1u);
    return b;
}
DI void xcd_barrier_complete(unsigned* bar, unsigned x, unsigned& nloc, unsigned& nx) {
    const unsigned Gt = gridDim.x * gridDim.y * gridDim.z;
    unsigned sum, cnt, mine, sp = 0u;
    for (;;) {
        sum = 0u; cnt = 0u; mine = 0u;
#pragma unroll
        for (unsigned j = 0; j < 16; ++j) { const unsigned c = xb_ld(&bar[XB_XCNT(j)]); sum += c; cnt += (c > 0u) ? 1u : 0u; mine = (j == x) ? c : mine; }
        if (sum == Gt) break;
        __builtin_amdgcn_s_sleep(1);
        if ((++sp & 255u) == 0u) { if (xb_ld(&bar[XB_TMO])) break; if (sp > XB_SPIN_CAP) { atomicAdd(&bar[XB_TMO], 1u); break; } }
    }
    nloc = mine > 0u ? mine : 1u; nx = cnt > 0u ? cnt : 1u;
}
DI void xcd_barrier(const XcdBarrier& b) {
    asm volatile("s_waitcnt vmcnt(0)" ::: "memory");
    __syncthreads();
    if (threadIdx.x == 0) {
        unsigned* bar = b.bar;
        __builtin_amdgcn_s_waitcnt(0);
        unsigned nloc = b.st[0], nx = b.st[1];
        if (nloc == 0u) { xcd_barrier_complete(bar, b.x, nloc, nx); b.st[0] = nloc; b.st[1] = nx; }
        const unsigned old = xb_add(&bar[XB_XSUB(b.x)], 1u);
        const unsigned gen = old / nloc;
        if (old + 1u == (gen + 1u) * nloc) {
            __builtin_amdgcn_fence(__ATOMIC_RELEASE, "agent");
            asm volatile("s_waitcnt vmcnt(0)" ::: "memory");
            const unsigned og = xb_add(&bar[XB_TOP], 1u);
            const unsigned tg = og / nx;
            if (og + 1u == (tg + 1u) * nx) xb_add(&bar[XB_TOPGEN], 1u);
            else XB_SPIN(xb_ld(&bar[XB_TOPGEN]) == tg, bar);
            __builtin_amdgcn_fence(__ATOMIC_ACQUIRE, "agent");
            xb_add(&bar[XB_XGEN(b.x)], 1u);
            asm volatile("s_waitcnt vmcnt(0)" ::: "memory");
        } else {
            XB_SPIN(xb_ld(&bar[XB_XGEN(b.x)]) == gen, bar);
            __builtin_amdgcn_fence(__ATOMIC_ACQUIRE, "agent");
            asm volatile("s_waitcnt vmcnt(0)" ::: "memory");
        }
    }
    __syncthreads();
}

__global__ void __launch_bounds__(512, 2) fwd_megakernel(Params p) {
    extern __shared__ __attribute__((aligned(16))) unsigned char smem[];
    LAS unsigned char* lds = (LAS unsigned char*)smem;
    cg::grid_group grid = cg::this_grid();
    const int G = gridDim.x, bx = blockIdx.x, nw = G * 8;
    volatile LAS unsigned* xst = (volatile LAS unsigned*)(lds + 131072);
    if (threadIdx.x == 0) { xst[0] = 0u; xst[1] = 0u; }
    __syncthreads();
    const XcdBarrier gbar = xcd_barrier_post((unsigned*)(p.ws + WS_BAR), xst);
#define LANE_ARGS(t_) (bx * 8 + __builtin_amdgcn_readfirstlane((t_) >> 6)), nw, ((t_) & 63)
    unsigned char* ws = p.ws;
    bf16_t* Win = (bf16_t*)(ws + WS_WIN); bf16_t* Wv = (bf16_t*)(ws + WS_WV); bf16_t* Wa = (bf16_t*)(ws + WS_WA); bf16_t* Wb = (bf16_t*)(ws + WS_WB);
    bf16_t* Wo = (bf16_t*)(ws + WS_WO); bf16_t* Wup = (bf16_t*)(ws + WS_WUP); bf16_t* Wdn = (bf16_t*)(ws + WS_WDN);
    float* mod = (float*)(ws + WS_MOD); bf16_t* ks = (bf16_t*)(ws + WS_KS); bf16_t* vts = (bf16_t*)(ws + WS_VTS);
    bf16_t* slot0 = (bf16_t*)(ws + WS_SLOT0);
    bf16_t* hbuf = (bf16_t*)(ws + WS_BIG);
    bf16_t* kbuf = (bf16_t*)(ws + WS_BIG + U); bf16_t* vT = (bf16_t*)(ws + WS_BIG + 2 * U);
    bf16_t* bg = (bf16_t*)(ws + WS_BIG + 3 * U); bf16_t* cu = (bf16_t*)(ws + WS_BIG + 4 * U);
    bf16_t* act = (bf16_t*)(ws + WS_ACT); bf16_t* hup = (bf16_t*)(ws + WS_HUP); bf16_t* hgt = (bf16_t*)(ws + WS_HGT); bf16_t* tup = (bf16_t*)(ws + WS_TUP); bf16_t* ugs = (bf16_t*)(ws + WS_UGS);
    bf16_t* sga = (bf16_t*)p.out; bf16_t* sgb = (bf16_t*)((unsigned char*)p.out + U);
    float* y = p.out + O_Y;
    bf16_t* xb = (bf16_t*)(ws + WS_BIG + 4 * U);

    phase_prep(p, lds, tid_());
    xcd_barrier(gbar);
    { const int t_ = tid_(); phase_norm_mod(p.x_prompt, p.x_sample, p.g_norm1, mod, 0, hbuf, LANE_ARGS(t_)); }
    xcd_barrier(gbar);
    { const int t_ = tid_(); sample_p2(hbuf, Win, Wv, slot0, ks, vts, bg, cu, sga, sgb, p.out, bx * 8 + __builtin_amdgcn_readfirstlane(t_ >> 6), t_ & 63); }
    { pg8::Gemm g{hbuf, Win, MP, N1, D, D, D}; pg8::StaticOrder S; S.init(MP, N1, G, bx);
      Epi1 E{slot0, kbuf, ks, bg, cu, sga, sgb, p.out}; pg8::gemm_phase<Epi1>(lds, g, S, E); }
    { pg8::Gemm g{Wv, hbuf, D, MP, D, D, D}; pg8::StaticOrder S; S.init(D, MP, G, bx);
      Epi1V E{vT, vts, p.out}; pg8::gemm_phase<Epi1V>(lds, g, S, E); }
    xcd_barrier(gbar);
    { const int t_ = tid_(); phase_attn(slot0, kbuf, vT, ks, vts, lds, __builtin_amdgcn_readfirstlane(t_ >> 6), LANE_ARGS(t_)); }
    { const int t_ = tid_(); phase_ob(p, bg, cu, LANE_ARGS(t_)); }
    xcd_barrier(gbar);
    { const int t_ = tid_(); if (t_ < 64) sample_p4(slot0, bg, Wa, Wb, sga, sgb, hbuf, bx, t_); }
    { pg8::Gemm g{slot0, Wa, MP, D, D, D, D}; pg8::StaticOrder S; S.init(MP, D, G, bx); EpiAB<0> E{sga, hbuf}; pg8::gemm_phase<EpiAB<0>>(lds, g, S, E, STAG_P4); }
    { pg8::Gemm g{bg, Wb, MP, D, D, D, D}; pg8::StaticOrder S; S.init(MP, D, G, bx); EpiAB<1> E{sgb, hbuf}; pg8::gemm_phase<EpiAB<1>>(lds, g, S, E); }
    xcd_barrier(gbar);
    { const int t_ = tid_(); if (t_ < 64) sample_res<0>(hbuf, D, Wo, D, p.x_sample, mod + 2 * D, xb, bx, t_); }
    { pg8::Gemm g{hbuf, Wo, MP, D, D, D, D}; pg8::StaticOrder S; S.init(MP, D, G, bx); EpiRes<0> E{p.x_prompt, mod, xb}; pg8::gemm_phase<EpiRes<0>>(lds, g, S, E, STAG_P5); }
    xcd_barrier(gbar);
    { const int t_ = tid_(); phase_norm_b<0>(xb, p.g_norm2, mod, 3 * D, slot0, nullptr, LANE_ARGS(t_)); }
    xcd_barrier(gbar);
    { const int t_ = tid_(); sample_up(slot0, Wup, ugs, p.out, bx * 8 + __builtin_amdgcn_readfirstlane(t_ >> 6), t_ & 63); }
    { pg8::Gemm g{slot0, Wup, MP, 2 * DFF, D, D, D}; pg8::StaticOrder S; S.init(MP, 2 * DFF, G, bx); EpiUp E{act, hup, hgt, tup, ugs, p.w_fconv, p.b_fconv, p.out}; pg8::gemm_phase<EpiUp>(lds, g, S, E); }
    xcd_barrier(gbar);
    { const int t_ = tid_(); phase_act_fix(p, act, hup, hgt, tup, ugs, LANE_ARGS(t_)); }
    xcd_barrier(gbar);
    { const int t_ = tid_(); if (t_ < 64) sample_res<1>(act, DFF, Wdn, DFF, nullptr, mod + 5 * D, xb, bx, t_); }
    { pg8::Gemm g{act, Wdn, MP, D, DFF, DFF, DFF}; pg8::StaticOrder S; S.init(MP, D, G, bx); EpiRes<1> E{nullptr, mod, xb}; pg8::gemm_phase<EpiRes<1>>(lds, g, S, E, STAG_P9); }
    xcd_barrier(gbar);
    { const int t_ = tid_(); phase_norm_b<1>(xb, p.g_final, nullptr, 0, nullptr, y, LANE_ARGS(t_)); }
    if (p.out == nullptr) grid.sync();
}

extern "C" void kernel_launch(void* const* d_in, const int* in_sizes, int n_in, void* d_out, int out_size, void* d_ws, size_t ws_size, hipStream_t stream) {
    static int grid_blocks = 0;
    if (grid_blocks == 0) {
        if (n_in != 23 || (size_t)out_size != O_END || ws_size < WS_BAR + XCD_BAR_WORDS * 4) { fprintf(stderr, "kernel_launch: unexpected shapes: n_in %d out %d ws %zu (need %zu)\n", n_in, out_size, ws_size, (size_t)WS_END); grid_blocks = -1; return; }
        int dev = 0, cus = 0, per_cu = 0;
        hipGetDevice(&dev);
        hipDeviceGetAttribute(&cus, hipDeviceAttributeMultiprocessorCount, dev);
        if (hipFuncSetAttribute((const void*)fwd_megakernel, hipFuncAttributeMaxDynamicSharedMemorySize, LDS_BYTES) != hipSuccess) { fprintf(stderr, "kernel_launch: hipFuncSetAttribute failed\n"); grid_blocks = -1; return; }
        hipOccupancyMaxActiveBlocksPerMultiprocessor(&per_cu, (const void*)fwd_megakernel, 512, LDS_BYTES);
        if (per_cu < 1) { fprintf(stderr, "kernel_launch: occupancy query says 0 blocks per CU\n"); per_cu = 1; }
        grid_blocks = cus * 1;
        (void)hipGetLastError();
    }
    if (grid_blocks < 0) return;
    if (hipMemsetAsync((char*)d_ws + WS_BAR, 0, XCD_BAR_WORDS * 4, stream) != hipSuccess) { fprintf(stderr, "kernel_launch: hipMemsetAsync of the barrier counter failed\n"); return; }
    Params p{};
    const float** pp = (const float**)&p;
    for (int i = 0; i < 23; ++i) pp[i] = (const float*)d_in[i];
    p.out = (float*)d_out; p.ws = (unsigned char*)d_ws;
    void* args[] = {&p};
    hipError_t e = hipLaunchCooperativeKernel((const void*)fwd_megakernel, dim3(grid_blocks), dim3(512), args, LDS_BYTES, stream);
    if (e != hipSuccess) fprintf(stderr, "cooperative launch failed: %s (grid %d)\n", hipGetErrorString(e), grid_blocks);
}
```

```cpp
#include <hip/hip_runtime.h>
#include <hip/hip_cooperative_groups.h>
#include <cstdio>
namespace cg = cooperative_groups;

#define LAS __attribute__((address_space(3)))
#define DI __device__ __forceinline__
typedef unsigned short bf16_t;
typedef short bf16x8 __attribute__((ext_vector_type(8)));
typedef short s16x4 __attribute__((ext_vector_type(4)));
typedef float f32x2 __attribute__((ext_vector_type(2)));
typedef float f32x4 __attribute__((ext_vector_type(4)));
typedef float f32x16 __attribute__((ext_vector_type(16)));
typedef unsigned u32x2 __attribute__((ext_vector_type(2)));
typedef unsigned u32x4 __attribute__((ext_vector_type(4)));
typedef __bf16 bf2_t __attribute__((ext_vector_type(2)));

constexpr int D = 1024, NB = 16, T = 4096, MP = NB * T, SB = 8, ST = 32, MS = SB * ST, M = MP + MS;
constexpr int PAST = 1024, SKV = PAST + ST, DFF = 2816, NH = 16, HD = 64, NMOD = 6 * D;
constexpr int N1 = 7168;
constexpr size_t O_Y = 0, O_KP = 67371008, O_VP = 134479872, O_CP = 201588736, O_FP = 201621504, O_KS = 201711616,
                 O_VS = 201973760, O_CS = 202235904, O_FS = 202252288, O_END = 202297344;
constexpr size_t U = (size_t)M * D * 2;
constexpr size_t WS_WIN = 0, WS_WV = WS_WIN + (size_t)N1 * D * 2, WS_WA = WS_WV + (size_t)D * D * 2, WS_WB = WS_WA + (size_t)D * D * 2,
                 WS_WO = WS_WB + (size_t)D * D * 2, WS_WUP = WS_WO + (size_t)D * D * 2, WS_WDN = WS_WUP + (size_t)2 * DFF * D * 2,
                 WS_MOD = WS_WDN + (size_t)D * DFF * 2, WS_KS = WS_MOD + (size_t)24 * NMOD * 4, WS_VTS = WS_KS + (size_t)SB * SKV * D * 2,
                 WS_SLOT0 = WS_VTS + (size_t)SB * D * SKV * 2, WS_BIG = WS_SLOT0 + U,
                 WS_ACT = WS_BIG,
                 WS_HUP = WS_ACT + (size_t)M * DFF * 2, WS_HGT = WS_HUP + (size_t)(MP / 64) * 2 * DFF * 2, WS_TUP = WS_HGT + (size_t)(MP / 64) * 2 * DFF * 2,
                 WS_UGS = WS_TUP + (size_t)(MP / 64) * 2 * DFF * 2, WS_ACT_END = WS_UGS + (size_t)MS * 2 * DFF * 2,
                 WS_END = (WS_BIG + 5 * U > WS_ACT_END) ? WS_BIG + 5 * U : WS_ACT_END;
constexpr int LDS_BYTES = 131072 + 64;
constexpr size_t WS_BAR = WS_END + 4096;
constexpr float QSCALE = 0.125f * 1.4426950408889634f;
#ifndef STAG_P4
#define STAG_P4 0
#define STAG_P5 0
#define STAG_P9 0
#endif

DI unsigned pk2(float lo, float hi) { f32x2 v = {lo, hi}; return __builtin_bit_cast(unsigned, __builtin_convertvector(v, bf2_t)); }
DI float bflo(unsigned w) { return __uint_as_float(w << 16); }
DI float bfhi(unsigned w) { return __uint_as_float(w & 0xffff0000u); }
DI u32x4 pk8(f32x4 a, f32x4 b) { u32x4 w; w.x = pk2(a[0], a[1]); w.y = pk2(a[2], a[3]); w.z = pk2(b[0], b[1]); w.w = pk2(b[2], b[3]); return w; }
DI float sigmoidf_(float x) { return __builtin_amdgcn_rcpf(1.0f + __expf(-x)); }
DI int tid_() { int t = threadIdx.x; asm volatile("" : "+v"(t)); return t; }
DI int bidx_of(int row) { return row < MP ? (row >> 12) : 16 + ((row - MP) >> 5); }

namespace pg8 {
constexpr int BM = 256, BK = 64, HALF = 128, HTB = HALF * BK * 2, STAGE_BYTES = 8 * HTB, NXCD = 8, WGM = 8;
DI int lds_byte(int r, int c) { const int st = (r >> 4) * 2 + (c >> 5), rr = r & 15, cc = c & 31, ob = rr * 64 + cc * 2; return st * 1024 + (ob ^ (((ob >> 9) & 1) << 5)); }
DI void stage_rc(int b, int& R, int& C) { const int st = b / 1024, sb = b % 1024, swz = sb ^ (((sb >> 9) & 1) << 5); R = (st >> 1) * 16 + swz / 64; C = (st & 1) * 32 + (swz % 64) / 2; }
DI int perm32(int rho) { const int n = rho >> 4, i = rho & 15; return 8 * (i >> 2) + 4 * n + (i & 3); }
struct Unit { int pm, pn; };
struct Gemm { const bf16_t* A; const bf16_t* Bt; int M, N, K, lda, ldb; };
struct StaticOrder {
    int nM, nN, nwg, G, c;
    DI void init(int M_, int N_, int G_, int c_) { nM = M_ / BM; nN = N_ / BM; nwg = nM * nN; G = G_; c = c_; }
    DI bool next(int i, Unit& u) const {
        const long L = (long)i * G + c; if (L >= nwg) return false;
        int wgid = (int)L; { const int q = nwg / NXCD, r = nwg % NXCD, xcd = wgid % NXCD, off = wgid / NXCD; wgid = (xcd < r ? xcd * (q + 1) : r * (q + 1) + (xcd - r) * q) + off; }
        const int nig = WGM * nN, gid = wgid / nig, fm = gid * WGM, gsz = (nM - fm) < WGM ? (nM - fm) : WGM;
        u.pm = fm + ((wgid % nig) % gsz); u.pn = (wgid % nig) / gsz; return true;
    }
};

template <class Epi>
DI void gemm_phase(LAS unsigned char* lds, const Gemm g, const StaticOrder& S, const Epi& E, int stag = 0) {
    const int tid = tid_(), wid = __builtin_amdgcn_readfirstlane(tid >> 6), lane = tid & 63, wr = wid >> 2, wc = wid & 3, fr = lane & 15, fq = lane >> 4;
    const int K = g.K, nt = K / BK;
    unsigned voffA[2], voffB[2];
#pragma unroll
    for (int i = 0; i < 2; ++i) { int R, C; stage_rc(tid * 16 + i * 8192, R, C); const int Rb = Epi::PERM ? ((R & ~31) + perm32(R & 31)) : R;
        voffA[i] = (unsigned)(R * g.lda + C) * 2u; voffB[i] = (unsigned)(Rb * g.ldb + C) * 2u; }
    const size_t kstep = (size_t)(BK * 2);
    const size_t hstepA = (size_t)HALF * g.lda * 2, hstepB = (size_t)HALF * g.ldb * 2;
    const size_t tstepA = 2 * hstepA, tstepB = 2 * hstepB;
    const unsigned ldsw = (unsigned)wid * 1024u;
    const int aoff = lds_byte(wr * 64 + fr, fq * 8), boff = lds_byte(wc * 32 + fr, fq * 8);
#define PG8_SA(b, h) (((b) * 2 + (h)) * HTB)
#define PG8_SB(b, h) ((4 + (b) * 2 + (h)) * HTB)
#define PG8_STAGE(bufoff, gbase, voff) do { _Pragma("unroll") for (int _i = 0; _i < 2; ++_i) \
        __builtin_amdgcn_global_load_lds((const unsigned*)((const char*)(gbase) + (voff)[_i]), (LAS unsigned*)(lds + (bufoff) + ldsw + _i * 8192), 16, 0, 0); } while (0)
#define PG8_LDA(dst, b, h) do { _Pragma("unroll") for (int m = 0; m < 4; ++m) _Pragma("unroll") for (int k = 0; k < 2; ++k) dst[m][k] = *(const LAS bf16x8*)(lds + PG8_SA(b, h) + aoff + m * 2048 + k * 1024); } while (0)
#define PG8_LDB(dst, b, h) do { _Pragma("unroll") for (int n = 0; n < 2; ++n) _Pragma("unroll") for (int k = 0; k < 2; ++k) dst[n][k] = *(const LAS bf16x8*)(lds + PG8_SB(b, h) + boff + n * 2048 + k * 1024); } while (0)
#define PG8_MMA(ai, bj, At, Bt) do { __builtin_amdgcn_s_setprio(1); _Pragma("unroll") for (int m = 0; m < 4; ++m) _Pragma("unroll") for (int n = 0; n < 2; ++n) _Pragma("unroll") for (int k = 0; k < 2; ++k) \
        acc[ai][bj][m][n] = __builtin_amdgcn_mfma_f32_16x16x32_bf16(Bt[n][k], At[m][k], acc[ai][bj][m][n], 0, 0, 0); __builtin_amdgcn_s_setprio(0); } while (0)
#define PG8_WAIT_V(n) asm volatile("s_waitcnt vmcnt(" #n ")" ::: "memory")
#define PG8_WAIT_L(n) asm volatile("s_waitcnt lgkmcnt(" #n ")" ::: "memory")
#define PG8_BAR __builtin_amdgcn_s_barrier()
#define PG8_SCHED __builtin_amdgcn_sched_barrier(0)
    Unit cur, nxt; int ui = 0;
    if (!S.next(0, cur)) return;
    if (stag) {
        const int slot = (blockIdx.x >> 3) & 15;
        if (slot) { const unsigned long long t0 = __builtin_amdgcn_s_memrealtime(), dl = (unsigned long long)(slot * stag) >> 4;
            while (__builtin_amdgcn_s_memrealtime() - t0 < dl) __builtin_amdgcn_s_sleep(8); }
    }
    f32x4 acc[2][2][4][2];
#pragma unroll
    for (int a = 0; a < 2; ++a)
#pragma unroll
        for (int b = 0; b < 2; ++b)
#pragma unroll
            for (int m = 0; m < 4; ++m)
#pragma unroll
                for (int n = 0; n < 2; ++n) acc[a][b][m][n] = (f32x4){0.f, 0.f, 0.f, 0.f};
    bf16x8 At[4][2], B0[2][2], B1[2][2];
    const char* cA = (const char*)g.A + (size_t)cur.pm * tstepA; const char* cB = (const char*)g.Bt + (size_t)cur.pn * tstepB;
    PG8_STAGE(PG8_SB(0, 0), cB, voffB); PG8_STAGE(PG8_SA(0, 0), cA, voffA); PG8_STAGE(PG8_SB(0, 1), cB + hstepB, voffB); PG8_STAGE(PG8_SA(0, 1), cA + hstepA, voffA);
    if (wr == 1) PG8_BAR;
    PG8_WAIT_V(4); PG8_BAR;
    PG8_STAGE(PG8_SB(1, 0), cB + kstep, voffB); PG8_STAGE(PG8_SA(1, 0), cA + kstep, voffA); PG8_STAGE(PG8_SB(1, 1), cB + hstepB + kstep, voffB);
    PG8_WAIT_V(6); PG8_BAR;
    for (;;) {
        const bool has_next = S.next(ui + 1, nxt);
        const char* nA = has_next ? (const char*)g.A + (size_t)nxt.pm * tstepA : cA; const char* nB = has_next ? (const char*)g.Bt + (size_t)nxt.pn * tstepB : cB;
        for (int t = 0; t < nt; t += 2) {
            const bool last = (t == nt - 2);
            const char* a1 = cA + (size_t)(t + 1) * kstep;
            const char* a2 = last ? nA : cA + (size_t)(t + 2) * kstep; const char* b2 = last ? nB : cB + (size_t)(t + 2) * kstep;
            const char* a3 = a2 + kstep; const char* b3 = b2 + kstep;
            PG8_LDB(B0, 0, 0); PG8_SCHED; PG8_LDA(At, 0, 0); PG8_STAGE(PG8_SA(1, 1), a1 + hstepA, voffA);
            PG8_WAIT_L(8); PG8_BAR; PG8_WAIT_L(0); PG8_MMA(0, 0, At, B0); PG8_BAR; PG8_SCHED;
            PG8_LDB(B1, 0, 1); PG8_STAGE(PG8_SB(0, 0), b2, voffB);
            PG8_BAR; PG8_WAIT_L(0); PG8_MMA(0, 1, At, B1); PG8_BAR;
            PG8_LDA(At, 0, 1); PG8_STAGE(PG8_SA(0, 0), a2, voffA);
            PG8_BAR; PG8_WAIT_L(0); PG8_MMA(1, 0, At, B0); PG8_BAR; PG8_SCHED;
            PG8_STAGE(PG8_SB(0, 1), b2 + hstepB, voffB);
            PG8_WAIT_V(6); PG8_BAR; PG8_MMA(1, 1, At, B1); PG8_BAR;
            PG8_LDB(B0, 1, 0); PG8_SCHED; PG8_LDA(At, 1, 0); PG8_STAGE(PG8_SA(0, 1), a2 + hstepA, voffA);
            PG8_WAIT_L(8); PG8_BAR; PG8_WAIT_L(0); PG8_MMA(0, 0, At, B0); PG8_BAR; PG8_SCHED;
            PG8_LDB(B1, 1, 1); PG8_STAGE(PG8_SB(1, 0), b3, voffB);
            PG8_BAR; PG8_WAIT_L(0); PG8_MMA(0, 1, At, B1); PG8_BAR;
            PG8_LDA(At, 1, 1); PG8_STAGE(PG8_SA(1, 0), a3, voffA);
            PG8_BAR; PG8_WAIT_L(0); PG8_MMA(1, 0, At, B0); PG8_BAR; PG8_SCHED;
            PG8_STAGE(PG8_SB(1, 1), b3 + hstepB, voffB);
            PG8_WAIT_V(6); PG8_BAR; PG8_MMA(1, 1, At, B1); PG8_BAR;
        }
        E(acc, cur, wr, wc, fr, fq);
        if (!has_next) break;
#pragma unroll
        for (int a = 0; a < 2; ++a)
#pragma unroll
            for (int b = 0; b < 2; ++b)
#pragma unroll
                for (int m = 0; m < 4; ++m)
#pragma unroll
                    for (int n = 0; n < 2; ++n) acc[a][b][m][n] = (f32x4){0.f, 0.f, 0.f, 0.f};
        cur = nxt; cA = nA; cB = nB; ++ui;
    }
    PG8_WAIT_V(0);
    if (wr == 0) PG8_BAR;
    PG8_BAR;
#undef PG8_SA
#undef PG8_SB
#undef PG8_STAGE
#undef PG8_LDA
#undef PG8_LDB
#undef PG8_MMA
#undef PG8_WAIT_V
#undef PG8_WAIT_L
#undef PG8_BAR
#undef PG8_SCHED
}
}
using pg8::Unit;
typedef const f32x4 (&AccRef)[2][2][4][2];

struct Epi1 {
    static constexpr bool PERM = true;
    bf16_t *q, *kbuf, *ks, *bg, *cu, *sga, *sgb; float* out;
    DI void operator()(AccRef acc, const Unit& u, int wr, int wc, int fr, int fq) const {
        asm volatile("" : "+v"(fr), "+v"(fq));
        const int pn = u.pn, rbase = u.pm * 256 + wr * 64 + fr, cl = wc * 32 + 8 * fq;
        if (pn >= 12 && pn < 20) {
            const int ch = (pn - 12) * 128 + cl;
#pragma unroll
            for (int ai = 0; ai < 2; ++ai)
#pragma unroll
                for (int m = 0; m < 4; ++m) {
                    const int row = rbase + ai * 128 + m * 16;
                    const f32x4 p0 = acc[ai][0][m][0] * acc[ai][1][m][0], p1 = acc[ai][0][m][1] * acc[ai][1][m][1];
                    *(u32x4*)(cu + (size_t)row * D + ch) = pk8(p0, p1);
                    float* dst = nullptr;
                    if (row < MP) { const int t = row & (T - 1); if (t >= T - 2) dst = out + O_CP + ((size_t)(row >> 12) * 2 + (t - (T - 2))) * D + ch; }
                    else { const int rs = row - MP, i = rs & 31; if (i >= ST - 2) dst = out + O_CS + ((size_t)(rs >> 5) * 2 + (i - (ST - 2))) * D + ch; }
                    if (dst) { *(f32x4*)dst = p0; *(f32x4*)(dst + 4) = p1; }
                }
            return;
        }
#pragma unroll
        for (int ai = 0; ai < 2; ++ai)
#pragma unroll
            for (int m = 0; m < 4; ++m) {
                const int row = rbase + ai * 128 + m * 16;
#pragma unroll
                for (int bj = 0; bj < 2; ++bj) {
                    f32x4 v0 = acc[ai][bj][m][0], v1 = acc[ai][bj][m][1];
                    if (pn < 4) { const int col = pn * 256 + bj * 128 + cl; *(u32x4*)(q + (size_t)row * D + col) = pk8(v0 * QSCALE, v1 * QSCALE); }
                    else if (pn < 8) {
                        const int col = (pn - 4) * 256 + bj * 128 + cl;
                        bf16_t* kd; float* od;
                        const int hh = col >> 6, dd = col & 63;
                        if (row < MP) { kd = kbuf + (((size_t)(row >> 12) * NH + hh) * T + (row & (T - 1))) * HD + dd; od = out + O_KP + (size_t)row * D + col; }
                        else { const int rs = row - MP; kd = ks + (((size_t)(rs >> 5) * NH + hh) * SKV + PAST + (rs & 31)) * HD + dd; od = out + O_KS + (size_t)rs * D + col; }
                        *(u32x4*)kd = pk8(v0, v1); *(f32x4*)od = v0; *(f32x4*)(od + 4) = v1;
                    }
                    else if (pn < 12) { const int col = (pn - 8) * 256 + bj * 128 + cl; *(u32x4*)(bg + (size_t)row * D + col) = pk8(v0, v1); }
                    else {
                        bf16_t* dst = (pn < 24) ? sga : sgb; const int col = ((pn - 20) & 3) * 256 + bj * 128 + cl;
#pragma unroll
                        for (int j = 0; j < 4; ++j) { v0[j] = sigmoidf_(v0[j]); v1[j] = sigmoidf_(v1[j]); }
                        *(u32x4*)(dst + (size_t)row * D + col) = pk8(v0, v1);
                    }
                }
            }
    }
};
struct Epi1V {
    static constexpr bool PERM = true;
    bf16_t *vT, *vts; float* out;
    DI void operator()(AccRef acc, const Unit& u, int wr, int wc, int fr, int fq) const {
        asm volatile("" : "+v"(fr), "+v"(fq));
        const int rbase = u.pm * 256 + wr * 64 + fr, cl = wc * 32 + 8 * fq;
#pragma unroll
        for (int ai = 0; ai < 2; ++ai)
#pragma unroll
            for (int m = 0; m < 4; ++m) {
                const int r = rbase + ai * 128 + m * 16;
#pragma unroll
                for (int bj = 0; bj < 2; ++bj) {
                    const int tok = u.pn * 256 + bj * 128 + cl;
                    const f32x4 v0 = acc[ai][bj][m][0], v1 = acc[ai][bj][m][1];
                    float* od;
                    const int hh = r >> 6, dd = r & 63; bf16_t* vd;
                    if (tok < MP) { const int t = tok & (T - 1); vd = vT + (((size_t)(tok >> 12) * NH + hh) * (T / 32) + (t >> 5)) * 2048 + dd * 32 + ((t & 31) >> 3) * 4; od = out + O_VP + (size_t)tok * D + r; }
                    else { const int ts = tok - MP; vd = vts + (((size_t)(ts >> 5) * NH + hh) * (SKV / 32) + PAST / 32) * 2048 + dd * 32 + ((ts & 31) >> 3) * 4; od = out + O_VS + (size_t)ts * D + r; }
                    { u32x2 w0, w1; w0.x = pk2(v0[0], v0[1]); w0.y = pk2(v0[2], v0[3]); w1.x = pk2(v1[0], v1[1]); w1.y = pk2(v1[2], v1[3]); *(u32x2*)vd = w0; *(u32x2*)(vd + 16) = w1; }
#pragma unroll
                    for (int j = 0; j < 4; ++j) { od[(size_t)j * D] = v0[j]; od[(size_t)(j + 4) * D] = v1[j]; }
                }
            }
    }
};
template <int MODE  > struct EpiAB {
    static constexpr bool PERM = true;
    const bf16_t* sg; bf16_t* tm;
    DI void operator()(AccRef acc, const Unit& u, int wr, int wc, int fr, int fq) const {
        asm volatile("" : "+v"(fr), "+v"(fq));
        const int rbase = u.pm * 256 + wr * 64 + fr, cb = u.pn * 256 + wc * 32 + 8 * fq;
#pragma unroll
        for (int ai = 0; ai < 2; ++ai) {
            u32x4 sv[4][2], pv[4][2];
#pragma unroll
            for (int m = 0; m < 4; ++m)
#pragma unroll
                for (int bj = 0; bj < 2; ++bj) { const size_t o = (size_t)(rbase + ai * 128 + m * 16) * D + cb + bj * 128;
                    sv[m][bj] = *(const u32x4*)(sg + o); if (MODE == 1) pv[m][bj] = *(const u32x4*)(tm + o); }
#pragma unroll
            for (int m = 0; m < 4; ++m)
#pragma unroll
                for (int bj = 0; bj < 2; ++bj) { const size_t o = (size_t)(rbase + ai * 128 + m * 16) * D + cb + bj * 128;
                    const u32x4 s = sv[m][bj];
                    f32x4 v0 = acc[ai][bj][m][0], v1 = acc[ai][bj][m][1];
                    v0[0] *= bflo(s.x); v0[1] *= bfhi(s.x); v0[2] *= bflo(s.y); v0[3] *= bfhi(s.y);
                    v1[0] *= bflo(s.z); v1[1] *= bfhi(s.z); v1[2] *= bflo(s.w); v1[3] *= bfhi(s.w);
                    if (MODE == 1) { const u32x4 p = pv[m][bj];
                        v0[0] += bflo(p.x); v0[1] += bfhi(p.x); v0[2] += bflo(p.y); v0[3] += bfhi(p.y);
                        v1[0] += bflo(p.z); v1[1] += bfhi(p.z); v1[2] += bflo(p.w); v1[3] += bfhi(p.w); }
                    *(u32x4*)(tm + o) = pk8(v0, v1); }
        }
    }
};
template <int MODE  > struct EpiRes {
    static constexpr bool PERM = true;
    const float *xp, *mod; bf16_t* xb;
    DI void operator()(AccRef acc, const Unit& u, int wr, int wc, int fr, int fq) const {
        asm volatile("" : "+v"(fr), "+v"(fq));
        const int rbase = u.pm * 256 + wr * 64 + fr, cb = u.pn * 256 + wc * 32 + 8 * fq;
        const float* gp = mod + (size_t)(u.pm >> 4) * NMOD + (MODE == 0 ? 2 * D : 5 * D) + cb;
        f32x4 gv[2][2];
#pragma unroll
        for (int bj = 0; bj < 2; ++bj)
#pragma unroll
            for (int n = 0; n < 2; ++n) gv[bj][n] = *(const f32x4*)(gp + bj * 128 + n * 4);
#pragma unroll
        for (int ai = 0; ai < 2; ++ai)
#pragma unroll
            for (int mp = 0; mp < 4; mp += 2) {
                f32x4 xv[2][2][2];
#pragma unroll
                for (int mm = 0; mm < 2; ++mm)
#pragma unroll
                    for (int bj = 0; bj < 2; ++bj) { const size_t o = (size_t)(rbase + ai * 128 + (mp + mm) * 16) * D + cb + bj * 128;
                        if (MODE == 0) { xv[mm][bj][0] = *(const f32x4*)(xp + o); xv[mm][bj][1] = *(const f32x4*)(xp + o + 4); }
                        else { const u32x4 w = *(const u32x4*)(xb + o); xv[mm][bj][0] = (f32x4){bflo(w.x), bfhi(w.x), bflo(w.y), bfhi(w.y)}; xv[mm][bj][1] = (f32x4){bflo(w.z), bfhi(w.z), bflo(w.w), bfhi(w.w)}; } }
#pragma unroll
                for (int mm = 0; mm < 2; ++mm)
#pragma unroll
                    for (int bj = 0; bj < 2; ++bj) { const size_t o = (size_t)(rbase + ai * 128 + (mp + mm) * 16) * D + cb + bj * 128;
                        *(u32x4*)(xb + o) = pk8(xv[mm][bj][0] + gv[bj][0] * acc[ai][bj][mp + mm][0], xv[mm][bj][1] + gv[bj][1] * acc[ai][bj][mp + mm][1]); }
            }
    }
};
DI void unpack8(const u32x4 w, float (&f)[8]) { f[0] = bflo(w.x); f[1] = bfhi(w.x); f[2] = bflo(w.y); f[3] = bfhi(w.y); f[4] = bflo(w.z); f[5] = bfhi(w.z); f[6] = bflo(w.w); f[7] = bfhi(w.w); }
DI u32x4 shfl4(const u32x4 w, int src) { u32x4 r; r.x = __shfl((int)w.x, src); r.y = __shfl((int)w.y, src); r.z = __shfl((int)w.z, src); r.w = __shfl((int)w.w, src); return r; }
struct EpiUp {
    static constexpr bool PERM = true;
    bf16_t *act, *hup, *hgt, *tup, *ugs; const float *wf, *bfc; float* out;
    DI void operator()(AccRef acc, const Unit& u, int wr, int wc, int fr, int fq) const {
        asm volatile("" : "+v"(fr), "+v"(fq));
        const int ch = u.pn * 128 + wc * 32 + 8 * fq;
        if (u.pm >= MP / 256) {
#pragma unroll
            for (int ai = 0; ai < 2; ++ai)
#pragma unroll
                for (int m = 0; m < 4; ++m) { const int rs = ai * 128 + wr * 64 + m * 16 + fr, i = rs & 31;
                    *(u32x4*)(ugs + (size_t)rs * (2 * DFF) + ch) = pk8(acc[ai][0][m][0], acc[ai][0][m][1]);
                    *(u32x4*)(ugs + (size_t)rs * (2 * DFF) + DFF + ch) = pk8(acc[ai][1][m][0], acc[ai][1][m][1]);
                    if (i >= ST - 2) { float* dst = out + O_FS + ((size_t)(rs >> 5) * 2 + (i - (ST - 2))) * DFF + ch; *(f32x4*)dst = acc[ai][0][m][0]; *(f32x4*)(dst + 4) = acc[ai][0][m][1]; } }
            return;
        }
        const int src1 = fq * 16 + ((fr - 1) & 15), src2 = fq * 16 + ((fr - 2) & 15);
        u32x2 ysave[2][4];
#pragma unroll
        for (int n = 0; n < 2; ++n) {
            const int ch4 = ch + 4 * n;
            const f32x4 w0 = *(const f32x4*)(wf + ch4), w1 = *(const f32x4*)(wf + DFF + ch4), w2 = *(const f32x4*)(wf + 2 * DFF + ch4), bb = *(const f32x4*)(bfc + ch4);
#pragma unroll
            for (int ai = 0; ai < 2; ++ai) {
                const int strip = u.pm * 4 + ai * 2 + wr, row0 = u.pm * 256 + ai * 128 + wr * 64 + fr;
                u32x2 r1p = {0u, 0u}, r2p = {0u, 0u};
#pragma unroll
                for (int m = 0; m < 4; ++m) {
                    const f32x4 ua = acc[ai][0][m][n], ga = acc[ai][1][m][n];
                    u32x2 upk; upk.x = pk2(ua[0], ua[1]); upk.y = pk2(ua[2], ua[3]);
                    u32x2 r1, r2; r1.x = __shfl((int)upk.x, src1); r1.y = __shfl((int)upk.y, src1); r2.x = __shfl((int)upk.x, src2); r2.y = __shfl((int)upk.y, src2);
                    u32x2 q1, q2; q1.x = fr == 0 ? r1p.x : r1.x; q1.y = fr == 0 ? r1p.y : r1.y; q2.x = fr < 2 ? r2p.x : r2.x; q2.y = fr < 2 ? r2p.y : r2.y;
                    r1p = r1; r2p = r2;
                    const f32x4 p1 = {bflo(q1.x), bfhi(q1.x), bflo(q1.y), bfhi(q1.y)}, p2 = {bflo(q2.x), bfhi(q2.x), bflo(q2.y), bfhi(q2.y)};
                    const f32x4 uc = w0 * p2 + w1 * p1 + w2 * ua + bb;
                    f32x4 yv;
#pragma unroll
                    for (int j = 0; j < 4; ++j) yv[j] = ga[j] * uc[j] * __builtin_amdgcn_rcpf(1.0f + __expf(-uc[j]));
                    u32x2 ypk; ypk.x = pk2(yv[0], yv[1]); ypk.y = pk2(yv[2], yv[3]);
                    const int row = row0 + m * 16;
                    if (m == 0 && fr < 2) {
                        u32x2 gpk; gpk.x = pk2(ga[0], ga[1]); gpk.y = pk2(ga[2], ga[3]);
                        *(u32x2*)(hup + ((size_t)strip * 2 + fr) * DFF + ch4) = upk;
                        *(u32x2*)(hgt + ((size_t)strip * 2 + fr) * DFF + ch4) = gpk;
                    } else if (n == 0) ysave[ai][m] = ypk;
                    else { u32x4 w; w.x = ysave[ai][m].x; w.y = ysave[ai][m].y; w.z = ypk.x; w.w = ypk.y; *(u32x4*)(act + (size_t)row * DFF + ch) = w; }
                    if (m == 3 && fr >= 14) {
                        *(u32x2*)(tup + ((size_t)strip * 2 + (fr - 14)) * DFF + ch4) = upk;
                        const int t = row & (T - 1);
                        if (t >= T - 2) *(f32x4*)(out + O_FP + ((size_t)(row >> 12) * 2 + (t - (T - 2))) * DFF + ch4) = ua;
                    }
                }
            }
        }
    }
};

DI int win_srccol(int n) {
    if (n < 2048) return n;
    if (n < 3072) return n + 1024;
    if (n < 5120) { const int j = (n - 3072) >> 8, r = (n - 3072) & 255; return r < 128 ? 4096 + 128 * j + r : 5120 + 128 * j + (r - 128); }
    return n + 1024;
}

DI int wup_srccol(int n) { const int j = n >> 8, r = n & 255; return r < 128 ? 128 * j + r : DFF + 128 * j + (r - 128); }

struct Params {
    const float *x_prompt, *x_sample, *cache_k, *cache_v, *state_conv, *state_ffn, *c_prompt, *c_sample, *w_ada, *b_ada, *g_norm1, *w_in, *w_conv, *b_conv,
                *w_branch_a, *w_branch_b, *w_out, *g_norm2, *w_up, *w_fconv, *b_fconv, *w_down, *g_final;
    float* out; unsigned char* ws;
};

DI void phase_prep(const Params& p, LAS unsigned char* lds, int tid) {
    LAS float* sm = (LAS float*)lds;
    unsigned char* ws = p.ws;
    const int G = gridDim.x, bx = blockIdx.x;
    constexpr int T_WIN = (N1 / 64) * 16, T_WV = 256, T_SQ = 256, T_WUP = (2 * DFF / 64) * 16, T_WDN = 16 * (DFF / 64), T_CV = SB * 256;
    constexpr int E1 = T_WIN, E2 = E1 + T_WV, E3 = E2 + T_SQ, E4 = E3 + T_SQ, E5 = E4 + T_SQ, E6 = E5 + T_WUP, E7 = E6 + T_WDN, E8 = E7 + T_CV;
    constexpr int S_WIN = (N1 / 64) * 4, S_WV = 64, S_SQ = 64, S_WUP = (2 * DFF / 64) * 4, S_WDN = 16 * (DFF / 256), S_CV = SB * 64;
    constexpr int F1 = S_WIN, F2 = F1 + S_WV, F3 = F2 + S_SQ, F4 = F3 + S_SQ, F5 = F4 + S_SQ, F6 = F5 + S_WUP, F7 = F6 + S_WDN, F8 = F7 + S_CV;
#define TILE_DESC(t, src, lds_, dst, ldd) do { \
        if (t < F1) { const int nt = t >> 2, kt = t & 3; src = p.w_in + (size_t)kt * 256 * 8192 + win_srccol(nt * 64); lds_ = 8192; dst = (bf16_t*)(ws + WS_WIN) + (size_t)nt * 64 * D + kt * 256; ldd = D; } \
        else if (t < F2) { const int q = t - F1, nt = q >> 2, kt = q & 3; src = p.w_in + (size_t)kt * 256 * 8192 + 2048 + nt * 64; lds_ = 8192; dst = (bf16_t*)(ws + WS_WV) + (size_t)nt * 64 * D + kt * 256; ldd = D; } \
        else if (t < F5) { const int w = (t - F2) >> 6, q = (t - F2) & 63, nt = q >> 2, kt = q & 3; \
            const float* sb = w == 0 ? p.w_branch_a : (w == 1 ? p.w_branch_b : p.w_out); const size_t off = w == 0 ? WS_WA : (w == 1 ? WS_WB : WS_WO); \
            src = sb + (size_t)kt * 256 * D + nt * 64; lds_ = D; dst = (bf16_t*)(ws + off) + (size_t)nt * 64 * D + kt * 256; ldd = D; } \
        else if (t < F6) { const int q = t - F5, nt = q >> 2, kt = q & 3; src = p.w_up + (size_t)kt * 256 * (2 * DFF) + wup_srccol(nt * 64); lds_ = 2 * DFF; dst = (bf16_t*)(ws + WS_WUP) + (size_t)nt * 64 * D + kt * 256; ldd = D; } \
        else if (t < F7) { const int q = t - F6, nt = q / (DFF / 256), kt = q % (DFF / 256); src = p.w_down + (size_t)kt * 256 * D + nt * 64; lds_ = D; dst = (bf16_t*)(ws + WS_WDN) + (size_t)nt * 64 * DFF + kt * 256; ldd = DFF; } \
        else { const int q = t - F7, b = q >> 6, nt = (q >> 2) & 15, kt = q & 3; \
            src = p.cache_v + (size_t)b * PAST * D + (size_t)kt * 256 * D + nt * 64; lds_ = D; dst = (bf16_t*)(ws + WS_VTS) + (((size_t)b * NH + nt) * (SKV / 32) + kt * 8) * 2048; ldd = -1; } } while (0)
    {
        const int c4 = tid & 15, kk0 = tid >> 4;
        const float* src; int lds_; bf16_t* dst; int ldd;
        f32x4 rv[8];
        if (bx < F8) { TILE_DESC(bx, src, lds_, dst, ldd);
#pragma unroll
            for (int i = 0; i < 8; ++i) rv[i] = *(const f32x4*)(src + (size_t)(kk0 + 32 * i) * lds_ + c4 * 4); }
        for (int t = bx; t < F8; t += G) {
#pragma unroll
            for (int i = 0; i < 8; ++i)
#pragma unroll
                for (int j = 0; j < 4; ++j) sm[(c4 * 4 + j) * 257 + kk0 + 32 * i] = rv[i][j];
            __syncthreads();
            bf16_t* cdst = dst; const int cldd = ldd;
            if (t + G < F8) { const int tn = t + G; TILE_DESC(tn, src, lds_, dst, ldd);
#pragma unroll
                for (int i = 0; i < 8; ++i) rv[i] = *(const f32x4*)(src + (size_t)(kk0 + 32 * i) * lds_ + c4 * 4); }
#pragma unroll
            for (int i = 0; i < 4; ++i) { const int n = (tid >> 5) + 16 * i, k8 = (tid & 31) * 8; const LAS float* s2 = sm + n * 257 + k8;
              u32x4 w; w.x = pk2(s2[0], s2[1]); w.y = pk2(s2[2], s2[3]); w.z = pk2(s2[4], s2[5]); w.w = pk2(s2[6], s2[7]);
              if (cldd > 0) *(u32x4*)(cdst + (size_t)n * cldd + k8) = w;
              else { bf16_t* vd = cdst + (size_t)(k8 >> 5) * 2048 + n * 32 + ((k8 & 31) >> 3) * 4; u32x2 a; a.x = w.x; a.y = w.y; u32x2 b2; b2.x = w.z; b2.y = w.w; *(u32x2*)vd = a; *(u32x2*)(vd + 16) = b2; } }
            __syncthreads();
        }
    }
#undef TILE_DESC
    { bf16_t* ks = (bf16_t*)(ws + WS_KS);
      for (size_t i = (size_t)bx * 512 + tid; i < (size_t)SB * PAST * D / 8; i += (size_t)G * 512) {
          const size_t e = i * 8; const int b = (int)(e / ((size_t)PAST * D)); const size_t r = e % ((size_t)PAST * D);
          const f32x4 a = *(const f32x4*)(p.cache_k + e), c = *(const f32x4*)(p.cache_k + e + 4);
          const int pos = (int)(r >> 10), hh = (int)(r >> 6) & 15, dd = (int)r & 63;
          *(u32x4*)(ks + (((size_t)b * NH + hh) * SKV + pos) * HD + dd) = pk8(a, c); } }
    for (int job = bx; job < NMOD / 32; job += G) {
        __syncthreads();
        for (int i = tid; i < 24 * D; i += 512) { const int r = i >> 10, k = i & 1023; const float c = r < 16 ? p.c_prompt[r * D + k] : p.c_sample[(r - 16) * D + k]; sm[i] = c / (1.0f + __expf(-c)); }
        __syncthreads();
        const int n = tid & 31, kq = tid >> 5, col = job * 32 + n;
        float a[24];
#pragma unroll
        for (int r = 0; r < 24; ++r) a[r] = 0.f;
        for (int k0 = kq * 64; k0 < kq * 64 + 64; k0 += 16) { float wv[16];
#pragma unroll
            for (int kk = 0; kk < 16; ++kk) wv[kk] = p.w_ada[(size_t)(k0 + kk) * NMOD + col];
#pragma unroll
            for (int kk = 0; kk < 16; ++kk)
#pragma unroll
                for (int r = 0; r < 24; ++r) a[r] += sm[r * D + k0 + kk] * wv[kk]; }
        __syncthreads();
#pragma unroll
        for (int r = 0; r < 24; ++r) sm[(kq * 24 + r) * 32 + n] = a[r];
        __syncthreads();
        for (int i = tid; i < 24 * 32; i += 512) { const int r = i >> 5, nn = i & 31; float s = p.b_ada[job * 32 + nn];
            for (int q = 0; q < 16; ++q) s += sm[(q * 24 + r) * 32 + nn];
            ((float*)(ws + WS_MOD))[(size_t)r * NMOD + job * 32 + nn] = s; }
    }
    __syncthreads();
}

DI void phase_norm_mod(const float* srcP, const float* srcS, const float* g, const float* mod, int shift_off, bf16_t* dst, int gw, int nw, int lane) {
    f32x4 gv[4];
#pragma unroll
    for (int i = 0; i < 4; ++i) gv[i] = *(const f32x4*)(g + lane * 4 + 256 * i);
    f32x4 cur[2][4], nxt[2][4];
#define NM_LOAD(dstv, r0) do { _Pragma("unroll") for (int rr = 0; rr < 2; ++rr) { const int row_ = (r0) + rr * nw; if (row_ < M) { \
        const float* s_ = row_ < MP ? srcP + (size_t)row_ * D : srcS + (size_t)(row_ - MP) * D; \
        _Pragma("unroll") for (int i = 0; i < 4; ++i) dstv[rr][i] = *(const f32x4*)(s_ + lane * 4 + 256 * i); } } } while (0)
    NM_LOAD(cur, gw);
    for (int row0 = gw; row0 < M; row0 += 2 * nw) {
        NM_LOAD(nxt, row0 + 2 * nw);
        f32x4 msh[4], msc[4];
        { const float* mp = mod + (size_t)bidx_of(row0) * NMOD + shift_off;
#pragma unroll
          for (int i = 0; i < 4; ++i) { const int c = lane * 4 + 256 * i; msh[i] = *(const f32x4*)(mp + c); msc[i] = *(const f32x4*)(mp + D + c); } }
#pragma unroll
        for (int rr = 0; rr < 2; ++rr) { const int row = row0 + rr * nw; if (row < M) {
            float ss = 0.f;
#pragma unroll
            for (int i = 0; i < 4; ++i) ss += cur[rr][i][0] * cur[rr][i][0] + cur[rr][i][1] * cur[rr][i][1] + cur[rr][i][2] * cur[rr][i][2] + cur[rr][i][3] * cur[rr][i][3];
#pragma unroll
            for (int o = 32; o >= 1; o >>= 1) ss += __shfl_xor(ss, o);
            const float rstd = rsqrtf(ss * (1.0f / D) + 1e-6f);
            if (rr == 1 && bidx_of(row) != bidx_of(row0)) { const float* mp = mod + (size_t)bidx_of(row) * NMOD + shift_off;
#pragma unroll
                for (int i = 0; i < 4; ++i) { const int c = lane * 4 + 256 * i; msh[i] = *(const f32x4*)(mp + c); msc[i] = *(const f32x4*)(mp + D + c); } }
#pragma unroll
            for (int i = 0; i < 4; ++i) { const int c = lane * 4 + 256 * i; const f32x4 sh = msh[i], sc = msc[i];
                const f32x4 h = cur[rr][i] * rstd * gv[i] * (sc + 1.0f) + sh;
                u32x2 w; w.x = pk2(h[0], h[1]); w.y = pk2(h[2], h[3]); *(u32x2*)(dst + (size_t)row * D + c) = w; } } }
#pragma unroll
        for (int rr = 0; rr < 2; ++rr)
#pragma unroll
            for (int i = 0; i < 4; ++i) cur[rr][i] = nxt[rr][i];
    }
#undef NM_LOAD
}
DI void phase_final_norm(float* y, const float* g, int gw, int nw, int lane) {
    f32x4 gv[4];
#pragma unroll
    for (int i = 0; i < 4; ++i) gv[i] = *(const f32x4*)(g + lane * 4 + 256 * i);
    f32x4 cur[2][4], nxt[2][4];
#define NM_LOAD(dstv, r0) do { _Pragma("unroll") for (int rr = 0; rr < 2; ++rr) { const int row_ = (r0) + rr * nw; if (row_ < M) { \
        const float* s_ = y + (size_t)row_ * D; \
        _Pragma("unroll") for (int i = 0; i < 4; ++i) dstv[rr][i] = *(const f32x4*)(s_ + lane * 4 + 256 * i); } } } while (0)
    NM_LOAD(cur, gw);
    for (int row0 = gw; row0 < M; row0 += 2 * nw) {
        NM_LOAD(nxt, row0 + 2 * nw);
#pragma unroll
        for (int rr = 0; rr < 2; ++rr) { const int row = row0 + rr * nw; if (row < M) {
            float ss = 0.f;
#pragma unroll
            for (int i = 0; i < 4; ++i) ss += cur[rr][i][0] * cur[rr][i][0] + cur[rr][i][1] * cur[rr][i][1] + cur[rr][i][2] * cur[rr][i][2] + cur[rr][i][3] * cur[rr][i][3];
#pragma unroll
            for (int o = 32; o >= 1; o >>= 1) ss += __shfl_xor(ss, o);
            const float rstd = rsqrtf(ss * (1.0f / D) + 1e-6f);
#pragma unroll
            for (int i = 0; i < 4; ++i) *(f32x4*)(y + (size_t)row * D + lane * 4 + 256 * i) = cur[rr][i] * rstd * gv[i]; } }
#pragma unroll
        for (int rr = 0; rr < 2; ++rr)
#pragma unroll
            for (int i = 0; i < 4; ++i) cur[rr][i] = nxt[rr][i];
    }
#undef NM_LOAD
}

template <int MODE> DI void phase_norm_b(const bf16_t* src, const float* g, const float* mod, int shift_off, bf16_t* dst, float* dstf, int gw, int nw, int lane) {
    f32x4 gv[4];
#pragma unroll
    for (int i = 0; i < 2; ++i) { gv[2 * i] = *(const f32x4*)(g + lane * 8 + 512 * i); gv[2 * i + 1] = *(const f32x4*)(g + lane * 8 + 512 * i + 4); }
    u32x4 cur[4][2], nxt[4][2];
#define NB_LOAD(dstv, r0) do { _Pragma("unroll") for (int rr = 0; rr < 4; ++rr) { const int row_ = (r0) + rr * nw; if (row_ < M) { \
        _Pragma("unroll") for (int i = 0; i < 2; ++i) dstv[rr][i] = *(const u32x4*)(src + (size_t)row_ * D + lane * 8 + 512 * i); } } } while (0)
    NB_LOAD(cur, gw);
    for (int row0 = gw; row0 < M; row0 += 4 * nw) {
        NB_LOAD(nxt, row0 + 4 * nw);
        f32x4 msh[2][4], msc[2][4];
        if (MODE == 0) {
#pragma unroll
            for (int pr = 0; pr < 2; ++pr) { const int row_ = row0 + 2 * pr * nw; if (row_ < M) { const float* mp = mod + (size_t)bidx_of(row_) * NMOD + shift_off;
#pragma unroll
                for (int i = 0; i < 2; ++i) { const int c = lane * 8 + 512 * i; msh[pr][2 * i] = *(const f32x4*)(mp + c); msh[pr][2 * i + 1] = *(const f32x4*)(mp + c + 4); msc[pr][2 * i] = *(const f32x4*)(mp + D + c); msc[pr][2 * i + 1] = *(const f32x4*)(mp + D + c + 4); } } }
        }
#pragma unroll
        for (int rr = 0; rr < 4; ++rr) { const int row = row0 + rr * nw; if (row < M) {
            f32x4 v[4];
#pragma unroll
            for (int i = 0; i < 2; ++i) { const u32x4 w = cur[rr][i]; v[2 * i] = (f32x4){bflo(w.x), bfhi(w.x), bflo(w.y), bfhi(w.y)}; v[2 * i + 1] = (f32x4){bflo(w.z), bfhi(w.z), bflo(w.w), bfhi(w.w)}; }
            float ss = 0.f;
#pragma unroll
            for (int i = 0; i < 4; ++i) ss += v[i][0] * v[i][0] + v[i][1] * v[i][1] + v[i][2] * v[i][2] + v[i][3] * v[i][3];
#pragma unroll
            for (int o = 32; o >= 1; o >>= 1) ss += __shfl_xor(ss, o);
            const float rstd = rsqrtf(ss * (1.0f / D) + 1e-6f);
            if (MODE == 0) {
                if ((rr & 1) && bidx_of(row) != bidx_of(row - nw)) {
                    const float* mp = mod + (size_t)bidx_of(row) * NMOD + shift_off;
#pragma unroll
                    for (int i = 0; i < 2; ++i) { const int c = lane * 8 + 512 * i; msh[rr >> 1][2 * i] = *(const f32x4*)(mp + c); msh[rr >> 1][2 * i + 1] = *(const f32x4*)(mp + c + 4); msc[rr >> 1][2 * i] = *(const f32x4*)(mp + D + c); msc[rr >> 1][2 * i + 1] = *(const f32x4*)(mp + D + c + 4); } }
#pragma unroll
                for (int i = 0; i < 2; ++i) { const int c = lane * 8 + 512 * i;
                    const f32x4 h0 = v[2 * i] * rstd * gv[2 * i] * (msc[rr >> 1][2 * i] + 1.0f) + msh[rr >> 1][2 * i];
                    const f32x4 h1 = v[2 * i + 1] * rstd * gv[2 * i + 1] * (msc[rr >> 1][2 * i + 1] + 1.0f) + msh[rr >> 1][2 * i + 1];
                    *(u32x4*)(dst + (size_t)row * D + c) = pk8(h0, h1); }
            } else {
#pragma unroll
                for (int i = 0; i < 2; ++i) { const int c = lane * 8 + 512 * i;
                    *(f32x4*)(dstf + (size_t)row * D + c) = v[2 * i] * rstd * gv[2 * i]; *(f32x4*)(dstf + (size_t)row * D + c + 4) = v[2 * i + 1] * rstd * gv[2 * i + 1]; }
            } } }
#pragma unroll
        for (int rr = 0; rr < 4; ++rr)
#pragma unroll
            for (int i = 0; i < 2; ++i) cur[rr][i] = nxt[rr][i];
    }
#undef NB_LOAD
}

DI void phase_ob(const Params& p, bf16_t* bg, const bf16_t* cu, int gw, int nw, int lane) {
    for (int item = gw; item < (M / 16) * 2; item += nw) {
        const int half = item & 1, row0 = (item >> 1) * 16, ch = half * 512 + lane * 8;
        float w0[8], w1[8], w2[8], bb[8], p2[8], p1[8];
#pragma unroll
        for (int j = 0; j < 8; ++j) { w0[j] = p.w_conv[ch + j]; w1[j] = p.w_conv[D + ch + j]; w2[j] = p.w_conv[2 * D + ch + j]; bb[j] = p.b_conv[ch + j]; }
        const bool start = row0 < MP ? ((row0 & (T - 1)) == 0) : (((row0 - MP) & 31) == 0);
        if (start) {
            if (row0 < MP) {
#pragma unroll
                for (int j = 0; j < 8; ++j) { p2[j] = 0.f; p1[j] = 0.f; } }
            else { const float* sc = p.state_conv + (size_t)((row0 - MP) >> 5) * 2 * D + ch;
#pragma unroll
                for (int j = 0; j < 8; ++j) { p2[j] = sc[j]; p1[j] = sc[D + j]; } }
        } else {
            const u32x4 a = *(const u32x4*)(cu + (size_t)(row0 - 2) * D + ch), b = *(const u32x4*)(cu + (size_t)(row0 - 1) * D + ch);
            p2[0] = bflo(a.x); p2[1] = bfhi(a.x); p2[2] = bflo(a.y); p2[3] = bfhi(a.y); p2[4] = bflo(a.z); p2[5] = bfhi(a.z); p2[6] = bflo(a.w); p2[7] = bfhi(a.w);
            p1[0] = bflo(b.x); p1[1] = bfhi(b.x); p1[2] = bflo(b.y); p1[3] = bfhi(b.y); p1[4] = bflo(b.z); p1[5] = bfhi(b.z); p1[6] = bflo(b.w); p1[7] = bfhi(b.w);
        }
#pragma unroll
        for (int rb = 0; rb < 16; rb += 8) {
            u32x4 cc[8], gq[8];
#pragma unroll
            for (int r = 0; r < 8; ++r) { const size_t o = (size_t)(row0 + rb + r) * D + ch; cc[r] = *(const u32x4*)(cu + o); gq[r] = *(const u32x4*)(bg + o); }
#pragma unroll
            for (int r = 0; r < 8; ++r) {
                const u32x4 c = cc[r], q4 = gq[r];
                float cur[8] = {bflo(c.x), bfhi(c.x), bflo(c.y), bfhi(c.y), bflo(c.z), bfhi(c.z), bflo(c.w), bfhi(c.w)};
                float gg[8] = {bflo(q4.x), bfhi(q4.x), bflo(q4.y), bfhi(q4.y), bflo(q4.z), bfhi(q4.z), bflo(q4.w), bfhi(q4.w)};
                float y[8];
#pragma unroll
                for (int j = 0; j < 8; ++j) { y[j] = gg[j] * (w0[j] * p2[j] + w1[j] * p1[j] + w2[j] * cur[j] + bb[j]); p2[j] = p1[j]; p1[j] = cur[j]; }
                u32x4 w; w.x = pk2(y[0], y[1]); w.y = pk2(y[2], y[3]); w.z = pk2(y[4], y[5]); w.w = pk2(y[6], y[7]);
                *(u32x4*)(bg + (size_t)(row0 + rb + r) * D + ch) = w;
            }
        }
    }
}
DI void phase_act_fix(const Params& p, bf16_t* act, const bf16_t* hup, const bf16_t* hgt, const bf16_t* tup, const bf16_t* ugs, int gw, int nw, int lane) {
    constexpr int NSTRIP = MP / 64, NFIX = NSTRIP * 6, NSMP = (MS / 16) * 11;
    for (int item = gw; item < NFIX + NSMP; item += nw) {
        if (item < NFIX) {
            const int strip = item / 6, slab = item % 6, ch = slab * 512 + lane * 8;
            if (ch >= DFF) continue;
            float w0[8], w1[8], w2[8], bb[8], p2[8], p1[8], c0[8], c1[8], g0[8], g1[8];
#pragma unroll
            for (int j = 0; j < 8; ++j) { w0[j] = p.w_fconv[ch + j]; w1[j] = p.w_fconv[DFF + ch + j]; w2[j] = p.w_fconv[2 * DFF + ch + j]; bb[j] = p.b_fconv[ch + j]; }
            if ((strip & 63) == 0) {
#pragma unroll
                for (int j = 0; j < 8; ++j) { p2[j] = 0.f; p1[j] = 0.f; } }
            else { unpack8(*(const u32x4*)(tup + ((size_t)(strip - 1) * 2) * DFF + ch), p2); unpack8(*(const u32x4*)(tup + ((size_t)(strip - 1) * 2 + 1) * DFF + ch), p1); }
            unpack8(*(const u32x4*)(hup + ((size_t)strip * 2) * DFF + ch), c0); unpack8(*(const u32x4*)(hup + ((size_t)strip * 2 + 1) * DFF + ch), c1);
            unpack8(*(const u32x4*)(hgt + ((size_t)strip * 2) * DFF + ch), g0); unpack8(*(const u32x4*)(hgt + ((size_t)strip * 2 + 1) * DFF + ch), g1);
            float y0[8], y1[8];
#pragma unroll
            for (int j = 0; j < 8; ++j) { const float ua = w0[j] * p2[j] + w1[j] * p1[j] + w2[j] * c0[j] + bb[j], ub = w0[j] * p1[j] + w1[j] * c0[j] + w2[j] * c1[j] + bb[j];
                y0[j] = g0[j] * ua / (1.0f + __expf(-ua)); y1[j] = g1[j] * ub / (1.0f + __expf(-ub)); }
            u32x4 a, b; a.x = pk2(y0[0], y0[1]); a.y = pk2(y0[2], y0[3]); a.z = pk2(y0[4], y0[5]); a.w = pk2(y0[6], y0[7]);
            b.x = pk2(y1[0], y1[1]); b.y = pk2(y1[2], y1[3]); b.z = pk2(y1[4], y1[5]); b.w = pk2(y1[6], y1[7]);
            *(u32x4*)(act + (size_t)(strip * 64) * DFF + ch) = a; *(u32x4*)(act + (size_t)(strip * 64 + 1) * DFF + ch) = b;
        } else {
            const int q = item - NFIX, slab = q % 11, row0 = (q / 11) * 16, ch = slab * 256 + lane * 4;
            float w0[4], w1[4], w2[4], bb[4], p2[4], p1[4];
#pragma unroll
            for (int j = 0; j < 4; ++j) { w0[j] = p.w_fconv[ch + j]; w1[j] = p.w_fconv[DFF + ch + j]; w2[j] = p.w_fconv[2 * DFF + ch + j]; bb[j] = p.b_fconv[ch + j]; }
            if ((row0 & 31) == 0) { const float* sc = p.state_ffn + (size_t)(row0 >> 5) * 2 * DFF + ch;
#pragma unroll
                for (int j = 0; j < 4; ++j) { p2[j] = sc[j]; p1[j] = sc[DFF + j]; } }
            else { const u32x2 a = *(const u32x2*)(ugs + (size_t)(row0 - 2) * (2 * DFF) + ch), b = *(const u32x2*)(ugs + (size_t)(row0 - 1) * (2 * DFF) + ch);
                p2[0] = bflo(a.x); p2[1] = bfhi(a.x); p2[2] = bflo(a.y); p2[3] = bfhi(a.y); p1[0] = bflo(b.x); p1[1] = bfhi(b.x); p1[2] = bflo(b.y); p1[3] = bfhi(b.y); }
            u32x2 cc[16], gq[16];
#pragma unroll
            for (int r = 0; r < 16; ++r) { const size_t o = (size_t)(row0 + r) * (2 * DFF) + ch; cc[r] = *(const u32x2*)(ugs + o); gq[r] = *(const u32x2*)(ugs + o + DFF); }
#pragma unroll
            for (int r = 0; r < 16; ++r) {
                const u32x2 c = cc[r], q2 = gq[r];
                float cur[4] = {bflo(c.x), bfhi(c.x), bflo(c.y), bfhi(c.y)};
                float gg[4] = {bflo(q2.x), bfhi(q2.x), bflo(q2.y), bfhi(q2.y)};
                float y[4];
#pragma unroll
                for (int j = 0; j < 4; ++j) { const float uc = w0[j] * p2[j] + w1[j] * p1[j] + w2[j] * cur[j] + bb[j]; y[j] = gg[j] * uc / (1.0f + __expf(-uc)); p2[j] = p1[j]; p1[j] = cur[j]; }
                u32x2 w; w.x = pk2(y[0], y[1]); w.y = pk2(y[2], y[3]);
                *(u32x2*)(act + (size_t)(MP + row0 + r) * DFF + ch) = w;
            }
        }
    }
}


#define MFMA32(a, b, c) __builtin_amdgcn_mfma_f32_32x32x16_bf16((a), (b), (c), 0, 0, 0)
DI void sg_mma(f32x16& acc, const bf16_t* X, int ldx, const bf16_t* Y, int ldy, int K, int lane) {
    const bf16_t* xp = X + (size_t)(lane & 31) * ldx + 8 * (lane >> 5);
    const bf16_t* yp = Y + (size_t)(lane & 31) * ldy + 8 * (lane >> 5);
    for (int k0 = 0; k0 < K; k0 += 128) {
        bf16x8 xa[8], yb[8];
#pragma unroll
        for (int s2 = 0; s2 < 8; ++s2) { xa[s2] = *(const bf16x8*)(xp + k0 + 16 * s2); yb[s2] = *(const bf16x8*)(yp + k0 + 16 * s2); }
#pragma unroll
        for (int s2 = 0; s2 < 8; ++s2) acc = MFMA32(xa[s2], yb[s2], acc);
    }
}
DI f32x16 zero16() { f32x16 z;
#pragma unroll
    for (int e = 0; e < 16; ++e) z[e] = 0.f; return z; }
DI void sg_mma_split(f32x16& acc, const bf16_t* X, int ldx, const bf16_t* Y, int ldy, int K, int wid, int lane, LAS float* red) {
    f32x16 part = zero16();
    for (int b = wid; b < (K >> 7); b += 8) sg_mma(part, X + b * 128, ldx, Y + b * 128, ldy, 128, lane);
#pragma unroll
    for (int e = 0; e < 16; e += 4) *(LAS f32x4*)(red + (size_t)(wid * 64 + lane) * 16 + e) = (f32x4){part[e], part[e + 1], part[e + 2], part[e + 3]};
    __syncthreads();
    if (wid == 0) {
#pragma unroll
        for (int w = 0; w < 8; ++w)
#pragma unroll
            for (int e = 0; e < 16; e += 4) { const f32x4 v = *(const LAS f32x4*)(red + (size_t)(w * 64 + lane) * 16 + e); acc[e] += v[0]; acc[e + 1] += v[1]; acc[e + 2] += v[2]; acc[e + 3] += v[3]; }
    }
    __syncthreads();
}
DI void st_bf4(bf16_t* p, float a, float b, float c, float d) { u32x2 w; w.x = pk2(a, b); w.y = pk2(c, d); *(u32x2*)p = w; }

DI void sample_p2(const bf16_t* hbuf, const bf16_t* Win, const bf16_t* Wv, bf16_t* q, bf16_t* ks, bf16_t* vts, bf16_t* bg, bf16_t* cu, bf16_t* sga, bf16_t* sgb, float* out, int gw, int lane) {
    if (gw >= 7 * 256) return;
    const int kind = gw >> 8, b = (gw >> 5) & 7, j = gw & 31, hf = lane >> 5, tl = lane & 31;
    const bf16_t* hrow = hbuf + (size_t)(MP + 32 * b) * D;
    const int row = MP + 32 * b + tl, rs = 32 * b + tl;
    if (kind == 6) {
        f32x16 acc = zero16(); sg_mma(acc, hrow, D, Wv + (size_t)(32 * j) * D, D, D, lane);
        const int dch = 32 * j + tl, hh = dch >> 6, dd = dch & 63;
#pragma unroll
        for (int g = 0; g < 4; ++g) {
            st_bf4(vts + (((size_t)b * NH + hh) * (SKV / 32) + PAST / 32) * 2048 + dd * 32 + 16 * hf + 4 * g, acc[4 * g], acc[4 * g + 1], acc[4 * g + 2], acc[4 * g + 3]);
#pragma unroll
            for (int e = 0; e < 4; ++e) out[O_VS + (size_t)(32 * b + 8 * g + 4 * hf + e) * D + dch] = acc[4 * g + e];
        }
        return;
    }
    if (kind == 3) {
        const int c0 = 32 * j, vC = 3072 + 256 * (c0 >> 7) + (c0 & 127);
        f32x16 aC = zero16(), aU = zero16();
        sg_mma(aC, Win + (size_t)vC * D, D, hrow, D, D, lane); sg_mma(aU, Win + (size_t)(vC + 128) * D, D, hrow, D, D, lane);
#pragma unroll
        for (int g = 0; g < 4; ++g) { const int c = c0 + 8 * g + 4 * hf; f32x4 pr = {aC[4 * g] * aU[4 * g], aC[4 * g + 1] * aU[4 * g + 1], aC[4 * g + 2] * aU[4 * g + 2], aC[4 * g + 3] * aU[4 * g + 3]};
            st_bf4(cu + (size_t)row * D + c, pr[0], pr[1], pr[2], pr[3]);
            if (tl >= ST - 2) *(f32x4*)(out + O_CS + ((size_t)b * 2 + (tl - (ST - 2))) * D + c) = pr; }
        return;
    }
    const int vbase = kind == 0 ? 0 : (kind == 1 ? 1024 : (kind == 2 ? 2048 : (kind == 4 ? 5120 : 6144)));
    f32x16 acc = zero16(); sg_mma(acc, Win + (size_t)(vbase + 32 * j) * D, D, hrow, D, D, lane);
#pragma unroll
    for (int g = 0; g < 4; ++g) { const int n = 32 * j + 8 * g + 4 * hf; const float a0 = acc[4 * g], a1 = acc[4 * g + 1], a2 = acc[4 * g + 2], a3 = acc[4 * g + 3];
        if (kind == 0) st_bf4(q + (size_t)row * D + n, a0 * QSCALE, a1 * QSCALE, a2 * QSCALE, a3 * QSCALE);
        else if (kind == 1) { st_bf4(ks + (((size_t)b * NH + (n >> 6)) * SKV + PAST + tl) * HD + (n & 63), a0, a1, a2, a3); *(f32x4*)(out + O_KS + (size_t)rs * D + n) = (f32x4){a0, a1, a2, a3}; }
        else if (kind == 2) st_bf4(bg + (size_t)row * D + n, a0, a1, a2, a3);
        else st_bf4((kind == 4 ? sga : sgb) + (size_t)row * D + n, sigmoidf_(a0), sigmoidf_(a1), sigmoidf_(a2), sigmoidf_(a3)); }
}
DI void sample_p4(const bf16_t* oa, const bf16_t* ob, const bf16_t* Wa, const bf16_t* Wb, const bf16_t* sga, const bf16_t* sgb, bf16_t* merged, int job, int wid, int lane, LAS float* red) {
    const int b = job >> 5, j = job & 31, hf = lane >> 5, tl = lane & 31, row = MP + 32 * b + tl;
    f32x16 aA = zero16(), aB = zero16();
    sg_mma_split(aA, Wa + (size_t)(32 * j) * D, D, oa + (size_t)(MP + 32 * b) * D, D, D, wid, lane, red); sg_mma_split(aB, Wb + (size_t)(32 * j) * D, D, ob + (size_t)(MP + 32 * b) * D, D, D, wid, lane, red);
    if (wid != 0) return;
#pragma unroll
    for (int g = 0; g < 4; ++g) { const size_t o = (size_t)row * D + 32 * j + 8 * g + 4 * hf; const u32x2 sa = *(const u32x2*)(sga + o), sb = *(const u32x2*)(sgb + o);
        st_bf4(merged + o, bflo(sa.x) * aA[4 * g] + bflo(sb.x) * aB[4 * g], bfhi(sa.x) * aA[4 * g + 1] + bfhi(sb.x) * aB[4 * g + 1],
               bflo(sa.y) * aA[4 * g + 2] + bflo(sb.y) * aB[4 * g + 2], bfhi(sa.y) * aA[4 * g + 3] + bfhi(sb.y) * aB[4 * g + 3]); }
}
template <int MODE> DI void sample_res(const bf16_t* A, int lda, const bf16_t* W, int K, const float* xs, const float* gate, bf16_t* xb, int job, int wid, int lane, LAS float* red) {
    const int b = job >> 5, j = job & 31, hf = lane >> 5, tl = lane & 31;
    f32x16 acc = zero16(); sg_mma_split(acc, W + (size_t)(32 * j) * K, K, A + (size_t)(MP + 32 * b) * lda, lda, K, wid, lane, red);
    if (wid != 0) return;
    const float* gp = gate + (size_t)(16 + b) * NMOD;
#pragma unroll
    for (int g = 0; g < 4; ++g) { const int n = 32 * j + 8 * g + 4 * hf; const f32x4 a = {acc[4 * g], acc[4 * g + 1], acc[4 * g + 2], acc[4 * g + 3]};
        bf16_t* dp = xb + (size_t)(MP + 32 * b + tl) * D + n; f32x4 x;
        if (MODE == 0) x = *(const f32x4*)(xs + (size_t)(32 * b + tl) * D + n);
        else { const u32x2 w = *(const u32x2*)dp; x = (f32x4){bflo(w.x), bfhi(w.x), bflo(w.y), bfhi(w.y)}; }
        const f32x4 r = x + *(const f32x4*)(gp + n) * a; st_bf4(dp, r[0], r[1], r[2], r[3]); }
}
DI void sample_up(const bf16_t* h2, const bf16_t* Wup, bf16_t* ugs, float* out, int gw, int lane) {
    if (gw >= 1408) return;
    const int isg = gw >= 704 ? 1 : 0, r = gw - 704 * isg, b = r / 88, j = r % 88, hf = lane >> 5, tl = lane & 31, c0 = 32 * j;
    const int vrow = 256 * (c0 >> 7) + (c0 & 127) + 128 * isg;
    f32x16 acc = zero16(); sg_mma(acc, Wup + (size_t)vrow * D, D, h2 + (size_t)(MP + 32 * b) * D, D, D, lane);
#pragma unroll
    for (int g = 0; g < 4; ++g) { const int c = c0 + 8 * g + 4 * hf;
        st_bf4(ugs + (size_t)(32 * b + tl) * (2 * DFF) + DFF * isg + c, acc[4 * g], acc[4 * g + 1], acc[4 * g + 2], acc[4 * g + 3]);
        if (!isg && tl >= ST - 2) *(f32x4*)(out + O_FS + ((size_t)b * 2 + (tl - (ST - 2))) * DFF + c) = (f32x4){acc[4 * g], acc[4 * g + 1], acc[4 * g + 2], acc[4 * g + 3]}; }
}

DI void phase_attn(bf16_t* qo, const bf16_t* kbuf, const bf16_t* vT, const bf16_t* ks, const bf16_t* vts, LAS unsigned char* lds, int wid, int gw, int nw, int lane) {
    const int hf = lane >> 5, tl = lane & 31;
    LAS unsigned char* myl = lds + wid * (32 * 144);
    constexpr int NITEM = NB * NH * (T / 32) + SB * NH;
    for (int item = gw; item < NITEM; item += nw) {
        int qt, h, qrow0; const bf16_t *K, *VT;
        if (item < NB * NH * (T / 32)) { qt = item & 127; h = (item >> 7) & 15; const int b = item >> 11; qrow0 = b * T + qt * 32;
            K = kbuf + ((size_t)(b * NH + h) * T) * HD; VT = vT + ((size_t)(b * NH + h) * (T / 32)) * 2048; }
        else { const int s = item - NB * NH * (T / 32); h = s & 15; const int b = s >> 4; qt = PAST / 32; qrow0 = MP + b * ST;
            K = ks + ((size_t)(b * NH + h) * SKV) * HD; VT = vts + ((size_t)(b * NH + h) * (SKV / 32)) * 2048; }
        bf16x8 qf[4];
        { const bf16_t* qp = qo + (size_t)(qrow0 + tl) * D + h * HD + 8 * hf;
#pragma unroll
          for (int s = 0; s < 4; ++s) qf[s] = *(const bf16x8*)(qp + 16 * s); }
        f32x16 O0, O1;
#pragma unroll
        for (int e = 0; e < 16; ++e) { O0[e] = 0.f; O1[e] = 0.f; }
        float carry = 0.f;
        bf16x8 kfA[4], vrA[2][2], kfB[4], vrB[2][2];
#define AT_LOAD(kfd, vrd, kb_) do { const bf16_t* kp_ = K + (size_t)((kb_) * 32 + tl) * HD + 8 * hf; const bf16_t* vp_ = VT + (size_t)(kb_) * 2048 + tl * 32 + hf * 16; \
        _Pragma("unroll") for (int s = 0; s < 4; ++s) kfd[s] = *(const bf16x8*)(kp_ + 16 * s); \
        _Pragma("unroll") for (int dt = 0; dt < 2; ++dt) _Pragma("unroll") for (int s = 0; s < 2; ++s) vrd[dt][s] = *(const bf16x8*)(vp_ + dt * 1024 + s * 8); } while (0)
#define AT_BLOCK(kf, vr, kfn, vrn, kb_, done_) do { \
            if ((kb_) > 0) AT_LOAD(kfn, vrn, (kb_) - 1); \
            f32x16 z = MFMA32(kf[0], qf[0], zc); \
            _Pragma("unroll") for (int s = 1; s < 4; ++s) z = MFMA32(kf[s], qf[s], z); \
            const bool diag = ((kb_) == qt); \
            float L[16]; \
            _Pragma("unroll") for (int e = 0; e < 16; ++e) { const float zz = z[e]; const float ex = __builtin_amdgcn_exp2f(-fabsf(zz)); \
                float l = -(__builtin_amdgcn_fmed3f(zz, 0.f, __builtin_inff()) + __builtin_amdgcn_logf(1.0f + ex)); \
                if (diag) { const int key = 8 * (e >> 2) + 4 * hf + (e & 3); if (key >= tl) l = 0.f; } \
                L[e] = l; } \
            float Gs[4], Gp[4]; \
            _Pragma("unroll") for (int g = 0; g < 4; ++g) { Gs[g] = (L[4 * g] + L[4 * g + 1]) + (L[4 * g + 2] + L[4 * g + 3]); Gp[g] = __shfl_xor(Gs[g], 32); } \
            float Tt[5]; Tt[4] = 0.f; \
            _Pragma("unroll") for (int g = 3; g >= 0; --g) Tt[g] = Tt[g + 1] + (Gs[g] + Gp[g]); \
            float a[16]; \
            _Pragma("unroll") for (int g = 0; g < 4; ++g) { \
                const float s3 = Tt[g + 1] + (hf == 0 ? Gp[g] : 0.f) + carry; \
                const float s2 = s3 + L[4 * g + 3], s1 = s2 + L[4 * g + 2], s0 = s1 + L[4 * g + 1]; \
                a[4 * g + 3] = __builtin_amdgcn_exp2f(z[4 * g + 3] + L[4 * g + 3] + s3); a[4 * g + 2] = __builtin_amdgcn_exp2f(z[4 * g + 2] + L[4 * g + 2] + s2); \
                a[4 * g + 1] = __builtin_amdgcn_exp2f(z[4 * g + 1] + L[4 * g + 1] + s1); a[4 * g] = __builtin_amdgcn_exp2f(z[4 * g] + L[4 * g] + s0); } \
            if (diag) { _Pragma("unroll") for (int e = 0; e < 16; ++e) { const int key = 8 * (e >> 2) + 4 * hf + (e & 3); if (key >= tl) a[e] = 0.f; } } \
            carry += Tt[0]; \
            _Pragma("unroll") for (int s = 0; s < 2; ++s) { \
                u32x4 aw; aw.x = pk2(a[8 * s], a[8 * s + 1]); aw.y = pk2(a[8 * s + 2], a[8 * s + 3]); aw.z = pk2(a[8 * s + 4], a[8 * s + 5]); aw.w = pk2(a[8 * s + 6], a[8 * s + 7]); \
                const bf16x8 af = __builtin_bit_cast(bf16x8, aw); \
                O0 = MFMA32(vr[0][s], af, O0); O1 = MFMA32(vr[1][s], af, O1); } \
              \
            done_ = ((kb_) == 0) || __all(carry < -151.0f); } while (0)
        const f32x16 zc = zero16();
        AT_LOAD(kfA, vrA, qt);
        for (int kb = qt; kb >= 0; kb -= 2) {
            bool done;
            AT_BLOCK(kfA, vrA, kfB, vrB, kb, done);
            if (done) break;
            AT_BLOCK(kfB, vrB, kfA, vrA, kb - 1, done);
            if (done) break;
        }
#undef AT_BLOCK
#undef AT_LOAD
#pragma unroll
        for (int g = 0; g < 4; ++g) {
            u32x2 w0; w0.x = pk2(O0[4 * g], O0[4 * g + 1]); w0.y = pk2(O0[4 * g + 2], O0[4 * g + 3]);
            u32x2 w1; w1.x = pk2(O1[4 * g], O1[4 * g + 1]); w1.y = pk2(O1[4 * g + 2], O1[4 * g + 3]);
            *(LAS u32x2*)(myl + tl * 144 + (8 * g + 4 * hf) * 2) = w0;
            *(LAS u32x2*)(myl + tl * 144 + (32 + 8 * g + 4 * hf) * 2) = w1;
        }
        asm volatile("s_waitcnt lgkmcnt(0)" ::: "memory");
#pragma unroll
        for (int it = 0; it < 4; ++it) { const int chunk = it * 64 + lane, row = chunk >> 3, c16 = chunk & 7;
            const u32x4 w = *(const LAS u32x4*)(myl + row * 144 + c16 * 16);
            *(u32x4*)(qo + (size_t)(qrow0 + row) * D + h * HD + c16 * 8) = w; }
        asm volatile("s_waitcnt lgkmcnt(0)" ::: "memory");
    }
}

#define XB_TMO      128
#define XB_XCNT(j)  (256  + 64 * (j))
#define XB_XSUB(j)  (1280 + 64 * (j))
#define XB_XGEN(j)  (2304 + 64 * (j))
#define XB_TOP      3328
#define XB_TOPGEN   3392
#define XCD_BAR_WORDS 3456
#define XB_SPIN_CAP (1u << 18)
DI unsigned xb_ld(unsigned* p) { return __hip_atomic_load(p, __ATOMIC_RELAXED, __HIP_MEMORY_SCOPE_AGENT); }
DI unsigned xb_add(unsigned* p, unsigned v) { return __hip_atomic_fetch_add(p, v, __ATOMIC_RELAXED, __HIP_MEMORY_SCOPE_AGENT); }
DI unsigned xb_xcc_id() { return (unsigned)__builtin_amdgcn_s_getreg((3 << 11) | 20) & 0xFu; }
#define XB_SPIN(cond, bar) do { unsigned _sp = 0; while (cond) { __builtin_amdgcn_s_sleep(1); \
    if ((++_sp & 255u) == 0u) { if (xb_ld(&(bar)[XB_TMO])) break; if (_sp > XB_SPIN_CAP) { atomicAdd(&(bar)[XB_TMO], 1u); break; } } } } while (0)
struct XcdBarrier { unsigned* bar; unsigned x; volatile LAS unsigned* st; };
DI XcdBarrier xcd_barrier_post(unsigned* bar, volatile LAS unsigned* st) {
    XcdBarrier b; b.bar = bar; b.x = xb_xcc_id(); b.st = st;
    if (threadIdx.x == 0) (void)xb_add(&bar[XB_XCNT(b.x)], 1u);
    return b;
}
DI void xcd_barrier_complete(unsigned* bar, unsigned x, unsigned& nloc, unsigned& nx) {
    const unsigned Gt = gridDim.x * gridDim.y * gridDim.z;
    unsigned sum, cnt, mine, sp = 0u;
    for (;;) {
        sum = 0u; cnt = 0u; mine = 0u;
#pragma unroll
        for (unsigned j = 0; j < 16; ++j) { const unsigned c = xb_ld(&bar[XB_XCNT(j)]); sum += c; cnt += (c > 0u) ? 1u : 0u; mine = (j == x) ? c : mine; }
        if (sum == Gt) break;
        __builtin_amdgcn_s_sleep(1);
        if ((++sp & 255u) == 0u) { if (xb_ld(&bar[XB_TMO])) break; if (sp > XB_SPIN_CAP) { atomicAdd(&bar[XB_TMO], 1u); break; } }
    }
    nloc = mine > 0u ? mine : 1u; nx = cnt > 0u ? cnt : 1u;
}
DI void xcd_barrier(const XcdBarrier& b) {
    asm volatile("s_waitcnt vmcnt(0)" ::: "memory");
    __syncthreads();
    if (threadIdx.x == 0) {
        unsigned* bar = b.bar;
        __builtin_amdgcn_s_waitcnt(0);
        unsigned nloc = b.st[0], nx = b.st[1];
        if (nloc == 0u) { xcd_barrier_complete(bar, b.x, nloc, nx); b.st[0] = nloc; b.st[1] = nx; }
        const unsigned old = xb_add(&bar[XB_XSUB(b.x)], 1u);
        const unsigned gen = old / nloc;
        if (old + 1u == (gen + 1u) * nloc) {
            __builtin_amdgcn_fence(__ATOMIC_RELEASE, "agent");
            asm volatile("s_waitcnt vmcnt(0)" ::: "memory");
            const unsigned og = xb_add(&bar[XB_TOP], 1u);
            const unsigned tg = og / nx;
            if (og + 1u == (tg + 1u) * nx) xb_add(&bar[XB_TOPGEN], 1u);
            else XB_SPIN(xb_ld(&bar[XB_TOPGEN]) == tg, bar);
            __builtin_amdgcn_fence(__ATOMIC_ACQUIRE, "agent");
            xb_add(&bar[XB_XGEN(b.x)], 1u);
            asm volatile("s_waitcnt vmcnt(0)" ::: "memory");
        } else {
            XB_SPIN(xb_ld(&bar[XB_XGEN(b.x)]) == gen, bar);
            __builtin_amdgcn_fence(__ATOMIC_ACQUIRE, "agent");
            asm volatile("s_waitcnt vmcnt(0)" ::: "memory");
        }
    }
    __syncthreads();
}

__global__ void __launch_bounds__(512, 2) fwd_megakernel(Params p) {
    extern __shared__ __attribute__((aligned(16))) unsigned char smem[];
    LAS unsigned char* lds = (LAS unsigned char*)smem;
    cg::grid_group grid = cg::this_grid();
    const int G = gridDim.x, bx = blockIdx.x, nw = G * 8;
    volatile LAS unsigned* xst = (volatile LAS unsigned*)(lds + 131072);
    if (threadIdx.x == 0) { xst[0] = 0u; xst[1] = 0u; }
    __syncthreads();
    const XcdBarrier gbar = xcd_barrier_post((unsigned*)(p.ws + WS_BAR), xst);
#define LANE_ARGS(t_) (bx * 8 + __builtin_amdgcn_readfirstlane((t_) >> 6)), nw, ((t_) & 63)
    unsigned char* ws = p.ws;
    bf16_t* Win = (bf16_t*)(ws + WS_WIN); bf16_t* Wv = (bf16_t*)(ws + WS_WV); bf16_t* Wa = (bf16_t*)(ws + WS_WA); bf16_t* Wb = (bf16_t*)(ws + WS_WB);
    bf16_t* Wo = (bf16_t*)(ws + WS_WO); bf16_t* Wup = (bf16_t*)(ws + WS_WUP); bf16_t* Wdn = (bf16_t*)(ws + WS_WDN);
    float* mod = (float*)(ws + WS_MOD); bf16_t* ks = (bf16_t*)(ws + WS_KS); bf16_t* vts = (bf16_t*)(ws + WS_VTS);
    bf16_t* slot0 = (bf16_t*)(ws + WS_SLOT0);
    bf16_t* hbuf = (bf16_t*)(ws + WS_BIG);
    bf16_t* kbuf = (bf16_t*)(ws + WS_BIG + U); bf16_t* vT = (bf16_t*)(ws + WS_BIG + 2 * U);
    bf16_t* bg = (bf16_t*)(ws + WS_BIG + 3 * U); bf16_t* cu = (bf16_t*)(ws + WS_BIG + 4 * U);
    bf16_t* act = (bf16_t*)(ws + WS_ACT); bf16_t* hup = (bf16_t*)(ws + WS_HUP); bf16_t* hgt = (bf16_t*)(ws + WS_HGT); bf16_t* tup = (bf16_t*)(ws + WS_TUP); bf16_t* ugs = (bf16_t*)(ws + WS_UGS);
    bf16_t* sga = (bf16_t*)p.out; bf16_t* sgb = (bf16_t*)((unsigned char*)p.out + U);
    float* y = p.out + O_Y;
    bf16_t* xb = (bf16_t*)(ws + WS_BIG + 4 * U);

    phase_prep(p, lds, tid_());
    xcd_barrier(gbar);
    { const int t_ = tid_(); phase_norm_mod(p.x_prompt, p.x_sample, p.g_norm1, mod, 0, hbuf, LANE_ARGS(t_)); }
    xcd_barrier(gbar);
    { const int t_ = tid_(); sample_p2(hbuf, Win, Wv, slot0, ks, vts, bg, cu, sga, sgb, p.out, bx * 8 + __builtin_amdgcn_readfirstlane(t_ >> 6), t_ & 63); }
    { pg8::Gemm g{hbuf, Win, MP, N1, D, D, D}; pg8::StaticOrder S; S.init(MP, N1, G, bx);
      Epi1 E{slot0, kbuf, ks, bg, cu, sga, sgb, p.out}; pg8::gemm_phase<Epi1>(lds, g, S, E); }
    { pg8::Gemm g{Wv, hbuf, D, MP, D, D, D}; pg8::StaticOrder S; S.init(D, MP, G, bx);
      Epi1V E{vT, vts, p.out}; pg8::gemm_phase<Epi1V>(lds, g, S, E); }
    xcd_barrier(gbar);
    { const int t_ = tid_(); phase_attn(slot0, kbuf, vT, ks, vts, lds, __builtin_amdgcn_readfirstlane(t_ >> 6), LANE_ARGS(t_)); }
    { const int t_ = tid_(); phase_ob(p, bg, cu, LANE_ARGS(t_)); }
    xcd_barrier(gbar);
    { const int t_ = tid_(); sample_p4(slot0, bg, Wa, Wb, sga, sgb, hbuf, bx, __builtin_amdgcn_readfirstlane(t_ >> 6), t_ & 63, (LAS float*)lds); }
    { pg8::Gemm g{slot0, Wa, MP, D, D, D, D}; pg8::StaticOrder S; S.init(MP, D, G, bx); EpiAB<0> E{sga, hbuf}; pg8::gemm_phase<EpiAB<0>>(lds, g, S, E, STAG_P4); }
    { pg8::Gemm g{bg, Wb, MP, D, D, D, D}; pg8::StaticOrder S; S.init(MP, D, G, bx); EpiAB<1> E{sgb, hbuf}; pg8::gemm_phase<EpiAB<1>>(lds, g, S, E); }
    xcd_barrier(gbar);
    { const int t_ = tid_(); sample_res<0>(hbuf, D, Wo, D, p.x_sample, mod + 2 * D, xb, bx, __builtin_amdgcn_readfirstlane(t_ >> 6), t_ & 63, (LAS float*)lds); }
    { pg8::Gemm g{hbuf, Wo, MP, D, D, D, D}; pg8::StaticOrder S; S.init(MP, D, G, bx); EpiRes<0> E{p.x_prompt, mod, xb}; pg8::gemm_phase<EpiRes<0>>(lds, g, S, E, STAG_P5); }
    xcd_barrier(gbar);
    { const int t_ = tid_(); phase_norm_b<0>(xb, p.g_norm2, mod, 3 * D, slot0, nullptr, LANE_ARGS(t_)); }
    xcd_barrier(gbar);
    { const int t_ = tid_(); sample_up(slot0, Wup, ugs, p.out, bx * 8 + __builtin_amdgcn_readfirstlane(t_ >> 6), t_ & 63); }
    { pg8::Gemm g{slot0, Wup, MP, 2 * DFF, D, D, D}; pg8::StaticOrder S; S.init(MP, 2 * DFF, G, bx); EpiUp E{act, hup, hgt, tup, ugs, p.w_fconv, p.b_fconv, p.out}; pg8::gemm_phase<EpiUp>(lds, g, S, E); }
    xcd_barrier(gbar);
    { const int t_ = tid_(); phase_act_fix(p, act, hup, hgt, tup, ugs, LANE_ARGS(t_)); }
    xcd_barrier(gbar);
    { const int t_ = tid_(); sample_res<1>(act, DFF, Wdn, DFF, nullptr, mod + 5 * D, xb, bx, __builtin_amdgcn_readfirstlane(t_ >> 6), t_ & 63, (LAS float*)lds); }
    { pg8::Gemm g{act, Wdn, MP, D, DFF, DFF, DFF}; pg8::StaticOrder S; S.init(MP, D, G, bx); EpiRes<1> E{nullptr, mod, xb}; pg8::gemm_phase<EpiRes<1>>(lds, g, S, E, STAG_P9); }
    xcd_barrier(gbar);
    { const int t_ = tid_(); phase_norm_b<1>(xb, p.g_final, nullptr, 0, nullptr, y, LANE_ARGS(t_)); }
    if (p.out == nullptr) grid.sync();
}

extern "C" void kernel_launch(void* const* d_in, const int* in_sizes, int n_in, void* d_out, int out_size, void* d_ws, size_t ws_size, hipStream_t stream) {
    static int grid_blocks = 0;
    if (grid_blocks == 0) {
        if (n_in != 23 || (size_t)out_size != O_END || ws_size < WS_BAR + XCD_BAR_WORDS * 4) { fprintf(stderr, "kernel_launch: unexpected shapes: n_in %d out %d ws %zu (need %zu)\n", n_in, out_size, ws_size, (size_t)WS_END); grid_blocks = -1; return; }
        int dev = 0, cus = 0, per_cu = 0;
        hipGetDevice(&dev);
        hipDeviceGetAttribute(&cus, hipDeviceAttributeMultiprocessorCount, dev);
        if (hipFuncSetAttribute((const void*)fwd_megakernel, hipFuncAttributeMaxDynamicSharedMemorySize, LDS_BYTES) != hipSuccess) { fprintf(stderr, "kernel_launch: hipFuncSetAttribute failed\n"); grid_blocks = -1; return; }
        hipOccupancyMaxActiveBlocksPerMultiprocessor(&per_cu, (const void*)fwd_megakernel, 512, LDS_BYTES);
        if (per_cu < 1) { fprintf(stderr, "kernel_launch: occupancy query says 0 blocks per CU\n"); per_cu = 1; }
        grid_blocks = cus * 1;
        (void)hipGetLastError();
    }
    if (grid_blocks < 0) return;
    if (hipMemsetAsync((char*)d_ws + WS_BAR, 0, XCD_BAR_WORDS * 4, stream) != hipSuccess) { fprintf(stderr, "kernel_launch: hipMemsetAsync of the barrier counter failed\n"); return; }
    Params p{};
    const float** pp = (const float**)&p;
    for (int i = 0; i < 23; ++i) pp[i] = (const float*)d_in[i];
    p.out = (float*)d_out; p.ws = (unsigned char*)d_ws;
    void* args[] = {&p};
    hipError_t e = hipLaunchCooperativeKernel((const void*)fwd_megakernel, dim3(grid_blocks), dim3(512), args, LDS_BYTES, stream);
    if (e != hipSuccess) fprintf(stderr, "cooperative launch failed: %s (grid %d)\n", hipGetErrorString(e), grid_blocks);
}
```
